# Optimizing an MI355X kernel written in HIP

```python
import math
import jax, jax.numpy as jnp
from jax import lax
import numpy as np

D_MODEL = 1024
BATCH = 32
SEQ = 2048
DEPTH = 1

N_META = 16
BLOCK_Q = 128
HEAD_DIM = 64
H_SB = 8
H_FOX = 8
W_SB = H_SB * HEAD_DIM
W_FOX = H_FOX * HEAD_DIM
D_FF = ((8 * D_MODEL // 3 + 127) // 128) * 128
CONV_W = 3
RMS_EPS = 1e-6
IN_SIZES = (W_SB, W_SB, W_SB, W_FOX, W_FOX, W_FOX, H_FOX, D_MODEL, D_MODEL)
IN_COLS = 3 * W_SB + 3 * W_FOX + H_FOX + 2 * D_MODEL

kernel_name = "hybrid_stickbreak_fox_convffn"


def rmsnorm(x, g):
    xf = x.astype(jnp.float32)
    r = lax.rsqrt(jnp.mean(xf * xf, axis=-1, keepdims=True) + RMS_EPS)
    return (xf * r).astype(x.dtype) * g


def split_heads(t, n_heads):
    b, l, _ = t.shape
    return t.reshape(b, l, n_heads, HEAD_DIM).transpose(0, 2, 1, 3)


def merge_heads(t):
    b, h, l, d = t.shape
    return t.transpose(0, 2, 1, 3).reshape(b, l, h * d)


def query_blocks(total_len):
    bounds = [(0, min(N_META, total_len))]
    for s in range(N_META, total_len, BLOCK_Q):
        bounds.append((s, min(s + BLOCK_Q, total_len)))
    return bounds


def stick_breaking_block(q, k, v, start):
    tq, tk = q.shape[2], k.shape[2]
    z = jnp.einsum('bhqd,bhkd->bhqk', q, k).astype(jnp.float32) / math.sqrt(HEAD_DIM)
    t_idx = start + jnp.arange(tq)[:, None]
    s_idx = jnp.arange(tk)[None, :]
    strict = s_idx < t_idx
    log_beta = jax.nn.log_sigmoid(z)
    log_keep = jnp.where(strict, jax.nn.log_sigmoid(-z), 0.0)
    after = lax.cumsum(log_keep, axis=3, reverse=True) - log_keep
    w = jnp.where(strict, jnp.exp(log_beta + after), 0.0)
    return jnp.einsum('bhqk,bhkd->bhqd', w.astype(v.dtype), v)


def forgetting_block(q, k, v, cum_log_f, start):
    tq, tk = q.shape[2], k.shape[2]
    z = jnp.einsum('bhqd,bhkd->bhqk', q, k).astype(jnp.float32) / math.sqrt(HEAD_DIM)
    z = z + cum_log_f[:, :, start:start + tq, None] - cum_log_f[:, :, None, :tk]
    t_idx = start + jnp.arange(tq)[:, None]
    s_idx = jnp.arange(tk)[None, :]
    z = jnp.where(s_idx <= t_idx, z, -jnp.inf)
    p = jax.nn.softmax(z, axis=-1)
    return jnp.einsum('bhqk,bhkd->bhqd', p.astype(v.dtype), v)


def hybrid_mixer(h, w_in, b_forget, w_branch_sb, w_branch_fox, w_out):
    total_len = h.shape[1]
    proj = h @ w_in
    split_at = np.cumsum(IN_SIZES)[:-1].tolist()
    q_sb, k_sb, v_sb, q_fx, k_fx, v_fx, f_logit, g_sb, g_fx = jnp.split(proj, split_at, axis=-1)
    q_sb, k_sb, v_sb = split_heads(q_sb, H_SB), split_heads(k_sb, H_SB), split_heads(v_sb, H_SB)
    q_fx, k_fx, v_fx = split_heads(q_fx, H_FOX), split_heads(k_fx, H_FOX), split_heads(v_fx, H_FOX)
    log_f = jax.nn.log_sigmoid(f_logit.astype(jnp.float32) + b_forget.astype(jnp.float32))
    cum_log_f = jnp.cumsum(log_f, axis=1).transpose(0, 2, 1)

    out_sb, out_fx = [], []
    for start, end in query_blocks(total_len):
        out_sb.append(stick_breaking_block(q_sb[:, :, start:end], k_sb[:, :, :end], v_sb[:, :, :end], start))
        out_fx.append(forgetting_block(q_fx[:, :, start:end], k_fx[:, :, :end], v_fx[:, :, :end], cum_log_f, start))
    o_sb = merge_heads(jnp.concatenate(out_sb, axis=2))
    o_fx = merge_heads(jnp.concatenate(out_fx, axis=2))

    merged = jax.nn.sigmoid(g_sb) * (o_sb @ w_branch_sb) + jax.nn.sigmoid(g_fx) * (o_fx @ w_branch_fox)
    return merged @ w_out


def conv_ffn(h, w_up, conv_w, w_down):
    total_len = h.shape[1]
    u = h @ w_up
    u_pad = jnp.pad(u, ((0, 0), (CONV_W - 1, 0), (0, 0)))
    uc = sum(conv_w[j] * u_pad[:, j:j + total_len] for j in range(CONV_W))
    a, b = jnp.split(uc, 2, axis=-1)
    return (jax.nn.silu(a) * b) @ w_down


def setup_inputs(seed: int = 0) -> dict:
    key = jax.random.key(seed)
    ks = jax.random.split(key, 14)
    f32 = jnp.float32
    x = jax.random.normal(ks[0], (BATCH, SEQ, D_MODEL), f32)
    meta_tokens = jax.random.normal(ks[1], (N_META, D_MODEL), f32)
    norm_mix_g = 1.0 + 0.02 * jax.random.normal(ks[2], (DEPTH, D_MODEL), f32)
    w_in = jax.random.normal(ks[3], (DEPTH, D_MODEL, IN_COLS), f32) * D_MODEL ** -0.5
    b_forget = jnp.linspace(1.0, 6.0, H_FOX, dtype=f32)[None, :] + 0.1 * jax.random.normal(ks[4], (DEPTH, H_FOX), f32)
    w_branch_sb = jax.random.normal(ks[5], (DEPTH, W_SB, D_MODEL), f32) * W_SB ** -0.5
    w_branch_fox = jax.random.normal(ks[6], (DEPTH, W_FOX, D_MODEL), f32) * W_FOX ** -0.5
    w_out = jax.random.normal(ks[7], (DEPTH, D_MODEL, D_MODEL), f32) * D_MODEL ** -0.5
    norm_ffn_g = 1.0 + 0.02 * jax.random.normal(ks[8], (DEPTH, D_MODEL), f32)
    w_up = jax.random.normal(ks[9], (DEPTH, D_MODEL, 2 * D_FF), f32) * D_MODEL ** -0.5
    conv_w = jax.random.normal(ks[10], (DEPTH, CONV_W, 2 * D_FF), f32) * CONV_W ** -0.5
    w_down = jax.random.normal(ks[11], (DEPTH, D_FF, D_MODEL), f32) * D_FF ** -0.5
    norm_final_g = 1.0 + 0.02 * jax.random.normal(ks[12], (D_MODEL,), f32)
    return {"x": x, "meta_tokens": meta_tokens, "norm_mix_g": norm_mix_g, "w_in": w_in,
            "b_forget": b_forget, "w_branch_sb": w_branch_sb, "w_branch_fox": w_branch_fox,
            "w_out": w_out, "norm_ffn_g": norm_ffn_g, "w_up": w_up, "conv_w": conv_w,
            "w_down": w_down, "norm_final_g": norm_final_g}


def reference(x, meta_tokens, norm_mix_g, w_in, b_forget, w_branch_sb, w_branch_fox,
              w_out, norm_ffn_g, w_up, conv_w, w_down, norm_final_g):
    b = x.shape[0]
    meta = jnp.broadcast_to(meta_tokens[None].astype(x.dtype), (b, N_META, D_MODEL))
    h = jnp.concatenate([meta, x], axis=1)
    for layer in range(DEPTH):
        h = h + hybrid_mixer(rmsnorm(h, norm_mix_g[layer]), w_in[layer], b_forget[layer],
                             w_branch_sb[layer], w_branch_fox[layer], w_out[layer])
        h = h + conv_ffn(rmsnorm(h, norm_ffn_g[layer]), w_up[layer], conv_w[layer], w_down[layer])
    return rmsnorm(h, norm_final_g)[:, N_META:]
```

```cpp
#include <hip/hip_runtime.h>
#include <hip/hip_cooperative_groups.h>
#include <cstdio>
#include <cstdint>
namespace cg = cooperative_groups;

#define LAS __attribute__((address_space(3)))
typedef unsigned short bf16_t;
typedef short bf16x8 __attribute__((ext_vector_type(8)));
typedef short s16x4 __attribute__((ext_vector_type(4)));
typedef float f32x2 __attribute__((ext_vector_type(2)));
typedef float f32x4 __attribute__((ext_vector_type(4)));
typedef float f32x16 __attribute__((ext_vector_type(16)));
typedef unsigned u32x2 __attribute__((ext_vector_type(2)));
typedef unsigned u32x4 __attribute__((ext_vector_type(4)));
typedef __bf16 bf16x2_t __attribute__((ext_vector_type(2)));

constexpr int NB = 32, SEQ = 2048, NMETA = 16, L = SEQ + NMETA, D = 1024, M = NB * L, DFF = 2816;
constexpr int NQKV = 3072, NGATE = 2048, NIN = 5120, INCOLS = 5128, NUP = 2 * DFF;
constexpr float EPS = 1e-6f, LOG2E = 1.4426950408889634f, C2 = 0.125f * LOG2E;
static_assert(M % 256 == 0, "M tiles");

constexpr size_t MiB = 1u << 20;
constexpr size_t WS_SS1 = 0, WS_SS2 = 512 * 1024, WS_FL = 1 * MiB, WS_CUM = 4 * MiB, WS_METAH = 7 * MiB;
constexpr size_t WS_WIN = 10 * MiB, WS_WBSB = 20 * MiB, WS_WBFX = 21 * MiB, WS_WOUT = 22 * MiB, WS_WUP = 24 * MiB, WS_WDN = 35 * MiB;
constexpr size_t WS_XN = 42 * MiB;
constexpr size_t WS_QKV = 172 * MiB;
constexpr size_t WS_G = 560 * MiB;
constexpr size_t WS_END = 818 * MiB;

__device__ __forceinline__ unsigned cvtpk(float lo, float hi) { f32x2 v = {lo, hi}; bf16x2_t b = __builtin_convertvector(v, bf16x2_t); return __builtin_bit_cast(unsigned, b); }
__device__ __forceinline__ float bflo(unsigned u) { return __uint_as_float(u << 16); }
__device__ __forceinline__ float bfhi(unsigned u) { return __uint_as_float(u & 0xffff0000u); }
__device__ __forceinline__ float sigmoid_(float x) { return __builtin_amdgcn_rcpf(1.f + __builtin_amdgcn_exp2f(-LOG2E * x)); }
__device__ __forceinline__ float wave_sum(float v) {
#pragma unroll
    for (int o = 1; o < 64; o <<= 1) v += __shfl_xor(v, o);
    return v;
}

namespace pg8 {
constexpr int BM = 256, BK = 64, HALF = 128, HTB = HALF * BK * 2, STAGE_BYTES = 8 * HTB, NXCD = 8, WGM = 8;
__host__ __device__ __forceinline__ int lds_byte(int r, int c) { const int st = (r >> 4) * 2 + (c >> 5), rr = r & 15, cc = c & 31, ob = rr * 64 + cc * 2; return st * 1024 + (ob ^ (((ob >> 9) & 1) << 5)); }
__host__ __device__ __forceinline__ void stage_rc(int b, int& R, int& C) { const int st = b / 1024, sb = b % 1024, swz = sb ^ (((sb >> 9) & 1) << 5); R = (st >> 1) * 16 + swz / 64; C = (st & 1) * 32 + (swz % 64) / 2; }
__host__ __device__ __forceinline__ int perm32(int rho) { const int n = rho >> 4, i = rho & 15; return 8 * (i >> 2) + 4 * n + (i & 3); }

struct Unit { int pm, pn; };
struct Gemm { const bf16_t* A; const bf16_t* Bt; int lda, K, mstep, moff; };

struct StaticOrder {
    int nM, nN, nwg, G, c;
    __device__ void init(int nM_, int nN_, int G_, int c_) { nM = nM_; nN = nN_; nwg = nM * nN; G = G_; c = c_; }
    __device__ bool next(int i, Unit& u) const {
        const long Lx = (long)i * G + c; if (Lx >= nwg) return false;
        int wgid = (int)Lx; { const int q = nwg / NXCD, r = nwg % NXCD, xcd = wgid % NXCD, off = wgid / NXCD; wgid = (xcd < r ? xcd * (q + 1) : r * (q + 1) + (xcd - r) * q) + off; }
        const int nig = WGM * nN, gid = wgid / nig, fm = gid * WGM, gsz = (nM - fm) < WGM ? (nM - fm) : WGM;
        u.pm = fm + ((wgid % nig) % gsz); u.pn = (wgid % nig) / gsz; return true;
    }
};

template <class Epi>
__device__ __forceinline__ void gemm_phase(LAS unsigned char* lds, const Gemm g, const StaticOrder& S, const Epi& E) {
    const int tid = threadIdx.x, wid = __builtin_amdgcn_readfirstlane(tid >> 6), lane = tid & 63, wr = wid >> 2, wc = wid & 3, fr = lane & 15, fq = lane >> 4;
    const int K = g.K, nt = K / BK, lda = g.lda;
    unsigned voffA[2], voffB[2];
#pragma unroll
    for (int i = 0; i < 2; ++i) { int R, C; stage_rc(tid * 16 + i * 8192, R, C); const int Rb = (R & ~31) + perm32(R & 31);
        voffA[i] = (unsigned)(R * lda + C) * 2u; voffB[i] = (unsigned)(Rb * K + C) * 2u; }
    const size_t kstep = (size_t)(BK * 2);
    const size_t hstA = (size_t)HALF * lda * 2, hstB = (size_t)HALF * K * 2;
    const unsigned ldsw = (unsigned)wid * 1024u;
    const int aoff = lds_byte(wr * 64 + fr, fq * 8), boff = lds_byte(wc * 32 + fr, fq * 8);
#define PG8_SA(b, h) (((b) * 2 + (h)) * HTB)
#define PG8_SB(b, h) ((4 + (b) * 2 + (h)) * HTB)
#define PG8_STAGE(bufoff, gbase, voff) do { _Pragma("unroll") for (int _i = 0; _i < 2; ++_i) \
        __builtin_amdgcn_global_load_lds((const unsigned*)((const char*)(gbase) + (voff)[_i]), (LAS unsigned*)(lds + (bufoff) + ldsw + _i * 8192), 16, 0, 0); } while (0)
#define PG8_LDA(dst, b, h) do { _Pragma("unroll") for (int m = 0; m < 4; ++m) _Pragma("unroll") for (int k = 0; k < 2; ++k) dst[m][k] = *(const LAS bf16x8*)(lds + PG8_SA(b, h) + aoff + m * 2048 + k * 1024); } while (0)
#define PG8_LDB(dst, b, h) do { _Pragma("unroll") for (int n = 0; n < 2; ++n) _Pragma("unroll") for (int k = 0; k < 2; ++k) dst[n][k] = *(const LAS bf16x8*)(lds + PG8_SB(b, h) + boff + n * 2048 + k * 1024); } while (0)
#define PG8_MMA(ai, bj, At, Bt) do { __builtin_amdgcn_s_setprio(1); _Pragma("unroll") for (int m = 0; m < 4; ++m) _Pragma("unroll") for (int n = 0; n < 2; ++n) _Pragma("unroll") for (int k = 0; k < 2; ++k) \
        acc[ai][bj][m][n] = __builtin_amdgcn_mfma_f32_16x16x32_bf16(Bt[n][k], At[m][k], acc[ai][bj][m][n], 0, 0, 0); __builtin_amdgcn_s_setprio(0); } while (0)
#define PG8_WAIT_V(n) asm volatile("s_waitcnt vmcnt(" #n ")" ::: "memory")
#define PG8_WAIT_L(n) asm volatile("s_waitcnt lgkmcnt(" #n ")" ::: "memory")
#define PG8_BAR __builtin_amdgcn_s_barrier()
#define PG8_SCHED __builtin_amdgcn_sched_barrier(0)
    Unit cur, nxt; int ui = 0;
    if (!S.next(0, cur)) return;
    f32x4 acc[2][2][4][2];
#pragma unroll
    for (int a = 0; a < 2; ++a)
#pragma unroll
        for (int b = 0; b < 2; ++b)
#pragma unroll
            for (int m = 0; m < 4; ++m)
#pragma unroll
                for (int n = 0; n < 2; ++n) acc[a][b][m][n] = (f32x4){0.f, 0.f, 0.f, 0.f};
    bf16x8 At[4][2], B0[2][2], B1[2][2];
    const char* cA = (const char*)g.A + ((long)cur.pm * g.mstep + g.moff) * (long)lda * 2; const char* cB = (const char*)g.Bt + (size_t)cur.pn * 2 * hstB;
    PG8_STAGE(PG8_SB(0, 0), cB, voffB); PG8_STAGE(PG8_SB(0, 1), cB + hstB, voffB); PG8_STAGE(PG8_SA(0, 0), cA, voffA); PG8_STAGE(PG8_SA(0, 1), cA + hstA, voffA);
    if (wr == 1) PG8_BAR;
    PG8_WAIT_V(2); PG8_BAR;
    PG8_STAGE(PG8_SB(1, 0), cB + kstep, voffB); PG8_STAGE(PG8_SA(1, 0), cA + kstep, voffA); PG8_STAGE(PG8_SB(1, 1), cB + hstB + kstep, voffB);
    PG8_WAIT_V(6); PG8_BAR;
    for (;;) {
        const bool has_next = S.next(ui + 1, nxt);
        const char* nA = has_next ? (const char*)g.A + ((long)nxt.pm * g.mstep + g.moff) * (long)lda * 2 : cA; const char* nB = has_next ? (const char*)g.Bt + (size_t)nxt.pn * 2 * hstB : cB;
        for (int t = 0; t < nt; t += 2) {
            const bool last = (t == nt - 2);
            const char* a1 = cA + (size_t)(t + 1) * kstep;
            const char* a2 = last ? nA : cA + (size_t)(t + 2) * kstep; const char* b2 = last ? nB : cB + (size_t)(t + 2) * kstep;
            const char* a3 = a2 + kstep; const char* b3 = b2 + kstep;
            PG8_LDB(B0, 0, 0); PG8_LDB(B1, 0, 1); PG8_SCHED; PG8_LDA(At, 0, 0); PG8_STAGE(PG8_SA(1, 1), a1 + hstA, voffA);
            PG8_WAIT_V(8); PG8_WAIT_L(0); PG8_BAR; PG8_MMA(0, 0, At, B0); PG8_MMA(0, 1, At, B1); PG8_BAR; PG8_SCHED;
            PG8_LDA(At, 0, 1); PG8_STAGE(PG8_SB(0, 0), b2, voffB); PG8_STAGE(PG8_SB(0, 1), b2 + hstB, voffB); PG8_STAGE(PG8_SA(0, 0), a2, voffA);
            PG8_WAIT_V(8); PG8_WAIT_L(0); PG8_BAR; PG8_MMA(1, 0, At, B0); PG8_MMA(1, 1, At, B1); PG8_BAR; PG8_SCHED;
            PG8_LDB(B0, 1, 0); PG8_LDB(B1, 1, 1); PG8_SCHED; PG8_LDA(At, 1, 0); PG8_STAGE(PG8_SA(0, 1), a2 + hstA, voffA);
            PG8_WAIT_V(8); PG8_WAIT_L(0); PG8_BAR; PG8_MMA(0, 0, At, B0); PG8_MMA(0, 1, At, B1); PG8_BAR; PG8_SCHED;
            PG8_LDA(At, 1, 1); PG8_STAGE(PG8_SB(1, 0), b3, voffB); PG8_STAGE(PG8_SB(1, 1), b3 + hstB, voffB); PG8_STAGE(PG8_SA(1, 0), a3, voffA);
            PG8_WAIT_V(8); PG8_WAIT_L(0); PG8_BAR; PG8_MMA(1, 0, At, B0); PG8_MMA(1, 1, At, B1); PG8_BAR; PG8_SCHED;
        }
        if (wr == 0) PG8_BAR;
        E(acc, cur, wr, wc, fr, fq);
        if (!has_next) break;
#pragma unroll
        for (int a = 0; a < 2; ++a)
#pragma unroll
            for (int b = 0; b < 2; ++b)
#pragma unroll
                for (int m = 0; m < 4; ++m)
#pragma unroll
                    for (int n = 0; n < 2; ++n) acc[a][b][m][n] = (f32x4){0.f, 0.f, 0.f, 0.f};
        cur = nxt; cA = nA; cB = nB; ++ui;
        if (wr == 1) PG8_BAR;
    }
    PG8_WAIT_V(0);
    PG8_BAR;
#undef PG8_SA
#undef PG8_SB
#undef PG8_STAGE
#undef PG8_LDA
#undef PG8_LDB
#undef PG8_MMA
}

typedef f32x4 Acc[2][2][4][2];
struct EpiIn {
    bf16_t* QKV; bf16_t* G;
    __device__ __forceinline__ void operator()(const Acc& acc, const Unit& u, int wr, int wc, int fr, int fq) const {
        const int row0 = u.pm * BM + wr * 64 + fr; const bool gate = u.pn >= 12;
        bf16_t* base; int ldc; float sc = 1.f;
        if (!gate) { base = QKV + u.pn * 256; ldc = NQKV; if (u.pn == 0 || u.pn == 1 || u.pn == 6 || u.pn == 7) sc = C2; } else { base = G + (u.pn - 12) * 256; ldc = NGATE; }
        const int col0 = wc * 32 + 8 * fq;
#pragma unroll
        for (int ai = 0; ai < 2; ++ai)
#pragma unroll
            for (int m = 0; m < 4; ++m) { bf16_t* rowp = base + (size_t)(row0 + ai * HALF + m * 16) * ldc + col0;
#pragma unroll
                for (int bj = 0; bj < 2; ++bj) { f32x4 v0 = acc[ai][bj][m][0], v1 = acc[ai][bj][m][1];
                    if (gate) {
#pragma unroll
                        for (int j = 0; j < 4; ++j) { v0[j] = sigmoid_(v0[j]); v1[j] = sigmoid_(v1[j]); } }
                    else { v0 = v0 * sc; v1 = v1 * sc; }
                    u32x4 w; w.x = cvtpk(v0[0], v0[1]); w.y = cvtpk(v0[2], v0[3]); w.z = cvtpk(v1[0], v1[1]); w.w = cvtpk(v1[2], v1[3]);
                    *(u32x4*)(rowp + bj * HALF) = w; } }
    }
};
template <int PASS> struct EpiBr {
    const bf16_t* G; bf16_t* MG;
    __device__ __forceinline__ void operator()(const Acc& acc, const Unit& u, int wr, int wc, int fr, int fq) const {
        const int row0 = u.pm * BM + wr * 64 + fr, col0 = u.pn * BM + wc * 32 + 8 * fq;
#pragma unroll
        for (int ai = 0; ai < 2; ++ai)
#pragma unroll
            for (int m = 0; m < 4; ++m) { const size_t row = (size_t)(row0 + ai * HALF + m * 16);
                const bf16_t* gp = G + row * NGATE + PASS * 1024 + col0; bf16_t* mp = MG + row * D + col0;
#pragma unroll
                for (int bj = 0; bj < 2; ++bj) { const u32x4 gv = *(const u32x4*)(gp + bj * HALF); f32x4 v0 = acc[ai][bj][m][0], v1 = acc[ai][bj][m][1];
                    v0[0] *= bflo(gv.x); v0[1] *= bfhi(gv.x); v0[2] *= bflo(gv.y); v0[3] *= bfhi(gv.y); v1[0] *= bflo(gv.z); v1[1] *= bfhi(gv.z); v1[2] *= bflo(gv.w); v1[3] *= bfhi(gv.w);
                    if (PASS == 1) { const u32x4 tv = *(const u32x4*)(mp + bj * HALF);
                        v0[0] += bflo(tv.x); v0[1] += bfhi(tv.x); v0[2] += bflo(tv.y); v0[3] += bfhi(tv.y); v1[0] += bflo(tv.z); v1[1] += bfhi(tv.z); v1[2] += bflo(tv.w); v1[3] += bfhi(tv.w); }
                    u32x4 w; w.x = cvtpk(v0[0], v0[1]); w.y = cvtpk(v0[2], v0[3]); w.z = cvtpk(v1[0], v1[1]); w.w = cvtpk(v1[2], v1[3]);
                    *(u32x4*)(mp + bj * HALF) = w; } }
    }
};
struct EpiOut {
    const float* x; const float* meta; float* out; float* metah; bf16_t* H1B; float* ss1;
    __device__ __forceinline__ void operator()(const Acc& acc, const Unit& u, int wr, int wc, int fr, int fq) const {
        const int row0 = u.pm * BM + wr * 64 + fr, col0 = u.pn * BM + wc * 32 + 8 * fq;
#pragma unroll
        for (int ai = 0; ai < 2; ++ai)
#pragma unroll
            for (int m = 0; m < 4; ++m) { const int row = row0 + ai * HALF + m * 16; const int b = row / L, t = row - b * L;
                const float* hs = (t < NMETA) ? meta + (size_t)t * D : x + ((size_t)b * SEQ + (t - NMETA)) * D;
                float* hd = (t < NMETA) ? metah + ((size_t)b * NMETA + t) * D : out + ((size_t)b * SEQ + (t - NMETA)) * D;
                float ss = 0.f;
#pragma unroll
                for (int bj = 0; bj < 2; ++bj) { const int c = col0 + bj * HALF;
                    const f32x4 h0 = *(const f32x4*)(hs + c), h1 = *(const f32x4*)(hs + c + 4);
                    const f32x4 v0 = acc[ai][bj][m][0] + h0, v1 = acc[ai][bj][m][1] + h1;
                    *(f32x4*)(hd + c) = v0; *(f32x4*)(hd + c + 4) = v1;
                    ss += (v0[0] * v0[0] + v0[1] * v0[1]) + (v0[2] * v0[2] + v0[3] * v0[3]) + (v1[0] * v1[0] + v1[1] * v1[1]) + (v1[2] * v1[2] + v1[3] * v1[3]);
                    u32x4 w; w.x = cvtpk(v0[0], v0[1]); w.y = cvtpk(v0[2], v0[3]); w.z = cvtpk(v1[0], v1[1]); w.w = cvtpk(v1[2], v1[3]);
                    *(u32x4*)(H1B + (size_t)row * D + c) = w; }
                ss += __shfl_xor(ss, 16); ss += __shfl_xor(ss, 32);
                if (fq == 0) atomicAdd(ss1 + row, ss); }
    }
};
__device__ __forceinline__ float fmac_ror1(float acc, float x, float c) { asm("s_nop 1\n\tv_fmac_f32_dpp %0, %1, %2 row_ror:1 row_mask:0xf bank_mask:0xf" : "+v"(acc) : "v"(x), "v"(c)); return acc; }
__device__ __forceinline__ float fmac_ror2(float acc, float x, float c) { asm("s_nop 1\n\tv_fmac_f32_dpp %0, %1, %2 row_ror:2 row_mask:0xf bank_mask:0xf" : "+v"(acc) : "v"(x), "v"(c)); return acc; }
struct EpiUp {
    const float* ss1; const float* convw; bf16_t* ACT; LAS float* halo;
    __device__ __forceinline__ void operator()(Acc& acc, const Unit& u, int wr, int wc, int fr, int fq) const {
        const int R0 = 254 * u.pm - 2;
        unsigned ok1 = 0, ok2 = 0, okst = 0;
#pragma unroll
        for (int ai = 0; ai < 2; ++ai)
#pragma unroll
            for (int m = 0; m < 4; ++m) { const int lr = ai * HALF + wr * 64 + m * 16 + fr, grow = R0 + lr; const bool inr = grow >= 0 && grow < M;
                const float r2 = inr ? __builtin_amdgcn_rsqf(ss1[inr ? grow : 0] * (1.f / D) + EPS) : 0.f;
                const int t = inr ? grow % L : 0;
                if (t >= 1) ok1 |= 1u << (ai * 4 + m); if (t >= 2) ok2 |= 1u << (ai * 4 + m); if (inr && lr >= 2) okst |= 1u << (ai * 4 + m);
#pragma unroll
                for (int bj = 0; bj < 2; ++bj)
#pragma unroll
                    for (int n = 0; n < 2; ++n) acc[ai][bj][m][n] = acc[ai][bj][m][n] * r2; }
        if (fr >= 14) {
#pragma unroll
            for (int ai = 0; ai < 2; ++ai)
#pragma unroll
                for (int bj = 0; bj < 2; ++bj)
#pragma unroll
                    for (int n = 0; n < 2; ++n) *(LAS f32x4*)(halo + ((ai * 2 + wr) * 2 + (fr - 14)) * 256 + bj * HALF + wc * 32 + 8 * fq + 4 * n) = acc[ai][bj][3][n];
        }
        asm volatile("s_waitcnt lgkmcnt(0)" ::: "memory"); __builtin_amdgcn_s_barrier(); asm volatile("" ::: "memory");
        const int chn = u.pn * 128 + wc * 32 + 8 * fq;
#pragma unroll
        for (int bj = 0; bj < 2; ++bj)
#pragma unroll
            for (int n = 0; n < 2; ++n) {
                asm volatile("" ::: "memory");
                const f32x4 c0 = *(const f32x4*)(convw + (size_t)0 * NUP + bj * DFF + chn + 4 * n), c1 = *(const f32x4*)(convw + (size_t)1 * NUP + bj * DFF + chn + 4 * n), c2 = *(const f32x4*)(convw + (size_t)2 * NUP + bj * DFF + chn + 4 * n);
#pragma unroll
                for (int ai = 0; ai < 2; ++ai) {
                    const int idx = ai * 2 + wr;
                    const f32x4 hreg = (idx > 0) ? *(const LAS f32x4*)(halo + ((idx - 1) * 2 + (fr == 15 ? 1 : 0)) * 256 + bj * HALF + wc * 32 + 8 * fq + 4 * n) : (f32x4){0.f, 0.f, 0.f, 0.f};
#pragma unroll
                    for (int m = 3; m >= 0; --m) {
                        const bool t1 = (ok1 >> (ai * 4 + m)) & 1u, t2 = (ok2 >> (ai * 4 + m)) & 1u;
                        const f32x4 cu = acc[ai][bj][m][n]; const f32x4 pv = (m > 0) ? acc[ai][bj][m > 0 ? m - 1 : 0][n] : hreg; f32x4 uc;
#pragma unroll
                        for (int j = 0; j < 4; ++j) { const float x1 = (fr == 15) ? pv[j] : cu[j], x2 = (fr >= 14) ? pv[j] : cu[j];
                            const float c1m = t1 ? c1[j] : 0.f, c0m = t2 ? c0[j] : 0.f;
                            uc[j] = fmac_ror2(fmac_ror1(c2[j] * cu[j], x1, c1m), x2, c0m); }
                        acc[ai][bj][m][n] = uc;
                    }
                }
                asm volatile("" ::: "memory"); __builtin_amdgcn_sched_barrier(0);
            }
#pragma unroll
        for (int ai = 0; ai < 2; ++ai)
#pragma unroll
            for (int m = 0; m < 4; ++m) {
                const f32x4 a0 = acc[ai][0][m][0], a1 = acc[ai][0][m][1], b0 = acc[ai][1][m][0], b1 = acc[ai][1][m][1];
                float v[8];
#pragma unroll
                for (int j = 0; j < 4; ++j) { v[j] = a0[j] * sigmoid_(a0[j]) * b0[j]; v[4 + j] = a1[j] * sigmoid_(a1[j]) * b1[j]; }
                if ((okst >> (ai * 4 + m)) & 1u) { u32x4 w; w.x = cvtpk(v[0], v[1]); w.y = cvtpk(v[2], v[3]); w.z = cvtpk(v[4], v[5]); w.w = cvtpk(v[6], v[7]);
                    const int grow = R0 + ai * HALF + wr * 64 + m * 16 + fr; *(u32x4*)(ACT + (size_t)grow * DFF + chn) = w; }
                __builtin_amdgcn_sched_barrier(0);
            }
    }
};
struct EpiDown {
    float* out; float* ss2;
    __device__ __forceinline__ void operator()(const Acc& acc, const Unit& u, int wr, int wc, int fr, int fq) const {
        const int row0 = u.pm * BM + wr * 64 + fr, col0 = u.pn * BM + wc * 32 + 8 * fq;
#pragma unroll
        for (int ai = 0; ai < 2; ++ai)
#pragma unroll
            for (int m = 0; m < 4; ++m) { const int row = row0 + ai * HALF + m * 16; const int b = row / L, t = row - b * L; const bool real = t >= NMETA;
                const int orow = b * SEQ + (real ? t - NMETA : 0); float* hd = out + (size_t)orow * D; float ss = 0.f;
                if (real) {
#pragma unroll
                    for (int bj = 0; bj < 2; ++bj) { const int c = col0 + bj * HALF;
                        const f32x4 h0 = *(const f32x4*)(hd + c), h1 = *(const f32x4*)(hd + c + 4);
                        const f32x4 v0 = acc[ai][bj][m][0] + h0, v1 = acc[ai][bj][m][1] + h1;
                        *(f32x4*)(hd + c) = v0; *(f32x4*)(hd + c + 4) = v1;
                        ss += (v0[0] * v0[0] + v0[1] * v0[1]) + (v0[2] * v0[2] + v0[3] * v0[3]) + (v1[0] * v1[0] + v1[1] * v1[1]) + (v1[2] * v1[2] + v1[3] * v1[3]); } }
                ss += __shfl_xor(ss, 16); ss += __shfl_xor(ss, 32);
                if (fq == 0 && real) atomicAdd(ss2 + orow, ss); }
    }
};
}

namespace att {
constexpr int SLOT = 16384, LDS_KB = 2 * SLOT;
__device__ __forceinline__ int crow(int r, int hi) { return (r & 3) + 8 * (r >> 2) + 4 * hi; }
__device__ __forceinline__ s16x4 vtr(const LAS unsigned char* p) { return __builtin_bit_cast(s16x4, __builtin_amdgcn_ds_read_tr16_b64_v4i16((LAS s16x4*)p)); }

template <bool FOX>
__device__ __forceinline__ void unit(bf16_t* QKV, const float* cum, int b, int h, int qt0, int nact, int NT, LAS unsigned char* lds) {
    const int tid = threadIdx.x, lane = tid & 63, r32 = lane & 31, hi = lane >> 5; const int wid = __builtin_amdgcn_readfirstlane(tid >> 6);
    const long rowbase = (long)b * L; const int colq = (FOX ? 1536 : 0) + h * 64, colk = colq + 512, colv = colq + 1024;
    const int tw0 = qt0 + 32 * wid, tq = tw0 + r32;
    LAS float* kbs = (LAS float*)(lds + LDS_KB);
    if (FOX) { for (int p = tid; p < 64 * NT; p += 512) { const int t = p - 48; kbs[p] = (t >= 0 && t < L) ? -cum[t] : 0.f; } }
    const int kkK = lane, kkV = 16 * (wid & 3) + (lane >> 2);
    const bf16_t* kcol = QKV + colk + wid * 8; const bf16_t* vcol = QKV + colv + (wid >> 2) * 32 + (lane & 3) * 8;
#define ATT_ISSUE(i, slot) do { const int tk_ = 64 * (i) - 48; int ta_ = tk_ + kkK; ta_ = ta_ < 0 ? 0 : ta_; int tb_ = tk_ + kkV; tb_ = tb_ < 0 ? 0 : tb_; \
        __builtin_amdgcn_global_load_lds((const unsigned*)(kcol + (rowbase + ta_) * NQKV), (LAS unsigned*)(lds + (slot) * SLOT + wid * 1024), 16, 0, 0); \
        __builtin_amdgcn_global_load_lds((const unsigned*)(vcol + (rowbase + tb_) * NQKV), (LAS unsigned*)(lds + (slot) * SLOT + 8192 + wid * 1024), 16, 0, 0); } while (0)
    ATT_ISSUE(FOX ? 0 : NT - 1, 0);
    bf16x8 qr[4];
    { const int tqc = tq < 0 ? 0 : tq; const bf16_t* qp = QKV + (rowbase + tqc) * NQKV + colq + hi * 8;
#pragma unroll
      for (int d0 = 0; d0 < 4; ++d0) qr[d0] = *(const bf16x8*)(qp + d0 * 16); }
    f32x16 o[2]; o[0] = f32x16{}; o[1] = f32x16{};
    float mref = 0.f, lsum = 0.f, carry = 0.f;
    const float him = hi == 0 ? 1.f : 0.f;
    asm volatile("s_waitcnt vmcnt(0) lgkmcnt(0)\n\ts_barrier" ::: "memory");
    for (int s = 0; s < NT; ++s) {
        const int i = FOX ? s : NT - 1 - s;
        if (s + 1 < NT) ATT_ISSUE(FOX ? s + 1 : NT - 2 - s, (s + 1) & 1);
        const int tk0 = 64 * i - 48;
        const bool skip = FOX ? (tk0 > tw0 + 31) : (tk0 >= tw0 + 31);
        if (wid < nact && !skip) {
            const LAS unsigned char* Ks = lds + (s & 1) * SLOT; const LAS unsigned char* Vs = Ks + 8192;
            const bool needmask = (i == 0) || (tk0 + 63 >= tw0);
            f32x16 p0, p1;
            if (FOX) {
#pragma unroll
                for (int g = 0; g < 4; ++g) { const f32x4 a = *(const LAS f32x4*)(kbs + 64 * i + 4 * hi + 8 * g), c = *(const LAS f32x4*)(kbs + 64 * i + 32 + 4 * hi + 8 * g);
#pragma unroll
                    for (int j = 0; j < 4; ++j) { p0[4 * g + j] = a[j] - mref; p1[4 * g + j] = c[j] - mref; } }
            } else { p0 = f32x16{}; p1 = f32x16{}; }
            const LAS unsigned char* kp = Ks + hi * 1024 + r32 * 16;
#pragma unroll
            for (int d0 = 0; d0 < 4; ++d0) { const bf16x8 a0 = *(const LAS bf16x8*)(kp + d0 * 2048), a1 = *(const LAS bf16x8*)(kp + d0 * 2048 + 512);
                p0 = __builtin_amdgcn_mfma_f32_32x32x16_bf16(a0, qr[d0], p0, 0, 0, 0); p1 = __builtin_amdgcn_mfma_f32_32x32x16_bf16(a1, qr[d0], p1, 0, 0, 0); }
            if (FOX) {
                if (needmask) {
#pragma unroll
                    for (int r = 0; r < 16; ++r) { const int tk = tk0 + crow(r, hi); if (!(tk >= 0 && tk <= tq)) p0[r] = -1e30f; if (!(tk + 32 >= 0 && tk + 32 <= tq)) p1[r] = -1e30f; } }
                float rm = p0[0];
#pragma unroll
                for (int r = 1; r < 16; ++r) rm = __builtin_fmaxf(rm, p0[r]);
#pragma unroll
                for (int r = 0; r < 16; ++r) rm = __builtin_fmaxf(rm, p1[r]);
                { auto rr = __builtin_amdgcn_permlane32_swap(__float_as_uint(rm), __float_as_uint(rm), false, false); rm = __builtin_fmaxf(__uint_as_float(rr[0]), __uint_as_float(rr[1])); }
                if (s == 0 || __any(rm > 8.f)) {
                    const float dl = (s == 0) ? rm : __builtin_fmaxf(rm, 0.f); mref += dl;
                    const float f = __builtin_amdgcn_exp2f(-dl); lsum *= f;
#pragma unroll
                    for (int r = 0; r < 16; ++r) { p0[r] -= dl; p1[r] -= dl; o[0][r] *= f; o[1][r] *= f; } }
                float sacc = 0.f;
#pragma unroll
                for (int r = 0; r < 16; ++r) { p0[r] = __builtin_amdgcn_exp2f(p0[r]); p1[r] = __builtin_amdgcn_exp2f(p1[r]); sacc += p0[r] + p1[r]; }
                lsum += sacc;
            } else {
                f32x16 s0, s1;
#pragma unroll
                for (int r = 0; r < 16; ++r) { const float z0 = __builtin_fminf(p0[r], 80.f), z1 = __builtin_fminf(p1[r], 80.f);
                    s0[r] = __builtin_amdgcn_logf(1.f + __builtin_amdgcn_exp2f(z0)); s1[r] = __builtin_amdgcn_logf(1.f + __builtin_amdgcn_exp2f(z1));
                    p0[r] = z0 - s0[r]; p1[r] = z1 - s1[r]; }
                if (needmask) {
#pragma unroll
                    for (int r = 0; r < 16; ++r) { const int tk = tk0 + crow(r, hi); const bool v0 = tk >= 0 && tk < tq, v1 = tk + 32 >= 0 && tk + 32 < tq;
                        s0[r] = v0 ? s0[r] : 0.f; p0[r] = v0 ? p0[r] : -1e30f; s1[r] = v1 ? s1[r] : 0.f; p1[r] = v1 ? p1[r] : -1e30f; } }
                float run = carry;
#pragma unroll
                for (int hf = 1; hf >= 0; --hf)
#pragma unroll
                    for (int g = 3; g >= 0; --g) {
                        f32x16& sp = hf ? s1 : s0; f32x16& pp = hf ? p1 : p0;
                        const float a2 = sp[4 * g + 3], a1 = a2 + sp[4 * g + 2], a0 = a1 + sp[4 * g + 1], G = a0 + sp[4 * g];
                        auto rr = __builtin_amdgcn_permlane32_swap(__float_as_uint(G), __float_as_uint(G), false, false);
                        const float base = run + him * __uint_as_float(rr[1]);
                        pp[4 * g + 3] = __builtin_amdgcn_exp2f(pp[4 * g + 3] - base); pp[4 * g + 2] = __builtin_amdgcn_exp2f(pp[4 * g + 2] - (base + a2));
                        pp[4 * g + 1] = __builtin_amdgcn_exp2f(pp[4 * g + 1] - (base + a1)); pp[4 * g] = __builtin_amdgcn_exp2f(pp[4 * g] - (base + a0));
                        run += __uint_as_float(rr[0]) + __uint_as_float(rr[1]);
                    }
                carry = run;
            }
            u32x4 pw[4];
#pragma unroll
            for (int k = 0; k < 2; ++k) { pw[k] = (u32x4){cvtpk(p0[8 * k], p0[8 * k + 1]), cvtpk(p0[8 * k + 2], p0[8 * k + 3]), cvtpk(p0[8 * k + 4], p0[8 * k + 5]), cvtpk(p0[8 * k + 6], p0[8 * k + 7])};
                pw[2 + k] = (u32x4){cvtpk(p1[8 * k], p1[8 * k + 1]), cvtpk(p1[8 * k + 2], p1[8 * k + 3]), cvtpk(p1[8 * k + 4], p1[8 * k + 5]), cvtpk(p1[8 * k + 6], p1[8 * k + 7])}; }
            const LAS unsigned char* vp = Vs + ((lane >> 4) & 1) * 32 + (lane & 3) * 8 + (4 * hi + ((lane & 15) >> 2)) * 64;
#pragma unroll
            for (int dh = 0; dh < 2; ++dh)
#pragma unroll
                for (int kg = 0; kg < 4; ++kg) { const s16x4 lo = vtr(vp + dh * 4096 + kg * 1024), hh = vtr(vp + dh * 4096 + kg * 1024 + 512);
                    const bf16x8 vf = (bf16x8){lo[0], lo[1], lo[2], lo[3], hh[0], hh[1], hh[2], hh[3]};
                    o[dh] = __builtin_amdgcn_mfma_f32_32x32x16_bf16(vf, __builtin_bit_cast(bf16x8, pw[kg]), o[dh], 0, 0, 0); }
        }
        asm volatile("s_waitcnt vmcnt(0) lgkmcnt(0)\n\ts_barrier" ::: "memory");
    }
#undef ATT_ISSUE
    if (wid < nact) {
        float inv = 1.f;
        if (FOX) { auto rr = __builtin_amdgcn_permlane32_swap(__float_as_uint(lsum), __float_as_uint(lsum), false, false); inv = 1.f / (__uint_as_float(rr[0]) + __uint_as_float(rr[1])); }
        if (tq >= 0) { bf16_t* op = QKV + (rowbase + tq) * NQKV + colq + 4 * hi;
#pragma unroll
            for (int dh = 0; dh < 2; ++dh)
#pragma unroll
                for (int g = 0; g < 4; ++g) { u32x2 w; w.x = cvtpk(o[dh][4 * g] * inv, o[dh][4 * g + 1] * inv); w.y = cvtpk(o[dh][4 * g + 2] * inv, o[dh][4 * g + 3] * inv);
                    *(u32x2*)(op + 32 * dh + 8 * g) = w; } }
    }
}
}

__device__ __forceinline__ void transpose_item(const float* W, int ldw, int K, bf16_t* WT, int k0, int dst0, int src0, const float* kscale, LAS float* scr, int lane) {
#pragma unroll 8
    for (int i = 0; i < 32; ++i) { const int kk = 2 * i + (lane >> 5); float v = W[(size_t)(k0 + kk) * ldw + src0 + (lane & 31)]; if (kscale) v *= kscale[k0 + kk]; scr[kk * 33 + (lane & 31)] = v; }
    asm volatile("s_waitcnt lgkmcnt(0)" ::: "memory");
    const int c = lane & 7;
#pragma unroll
    for (int j = 0; j < 4; ++j) { const int n = (lane >> 3) + 8 * j; const LAS float* s = scr + (8 * c) * 33 + n;
        u32x4 o; o.x = cvtpk(s[0 * 33], s[1 * 33]); o.y = cvtpk(s[2 * 33], s[3 * 33]); o.z = cvtpk(s[4 * 33], s[5 * 33]); o.w = cvtpk(s[6 * 33], s[7 * 33]);
        *(u32x4*)(WT + (size_t)(dst0 + n) * K + k0 + 8 * c) = o; }
    asm volatile("s_waitcnt lgkmcnt(0)" ::: "memory");
}

struct Args { const float *x, *meta, *g1, *w_in, *bf, *wbsb, *wbfx, *wout, *g2, *wup, *convw, *wdown, *gf; float* out; unsigned char* ws; };

constexpr int LDS_BYTES = 147456;
__global__ void __launch_bounds__(512, 2) fwd_mega(Args a) {
    extern __shared__ __attribute__((aligned(16))) unsigned char lds_[];
    LAS unsigned char* lds = (LAS unsigned char*)lds_;
    cg::grid_group grid = cg::this_grid();
    const int tid = threadIdx.x, lane = tid & 63, wave = __builtin_amdgcn_readfirstlane(tid >> 6);
    const int G = gridDim.x, bx = blockIdx.x;
    const int gw = bx * 8 + wave, NGW = G * 8;
    unsigned char* ws = a.ws;
    float* ss1 = (float*)(ws + WS_SS1); float* ss2 = (float*)(ws + WS_SS2); float* fl = (float*)(ws + WS_FL); float* cum = (float*)(ws + WS_CUM); float* metah = (float*)(ws + WS_METAH);
    bf16_t* Win_t = (bf16_t*)(ws + WS_WIN); bf16_t* Wbsb_t = (bf16_t*)(ws + WS_WBSB); bf16_t* Wbfx_t = (bf16_t*)(ws + WS_WBFX); bf16_t* Wout_t = (bf16_t*)(ws + WS_WOUT);
    bf16_t* Wup_t = (bf16_t*)(ws + WS_WUP); bf16_t* Wdn_t = (bf16_t*)(ws + WS_WDN);
    bf16_t* XN = (bf16_t*)(ws + WS_XN); bf16_t* QKV = (bf16_t*)(ws + WS_QKV); bf16_t* GT = (bf16_t*)(ws + WS_G); bf16_t* H1B = GT; bf16_t* ACT = QKV; bf16_t* MG = XN;

    {
        LAS float* scr = (LAS float*)(lds + wave * 8704);
        LAS float* wfl = (LAS float*)(lds + 69632);
        for (int idx = tid; idx < 8192; idx += 512) { const int k = idx >> 3, j = idx & 7; wfl[j * 1024 + k] = a.w_in[(size_t)k * INCOLS + NQKV + j]; }
        for (int i = bx * 512 + tid; i < M; i += G * 512) { ss1[i] = 0.f; if (i < NB * SEQ) ss2[i] = 0.f; }
        constexpr int I_IN = 16 * 160, I_BR = 8 * 32, I_OUT = 16 * 32, I_UP = 16 * 176, I_DN = 44 * 32;
        constexpr int NITEMS = I_IN + 2 * I_BR + I_OUT + I_UP + I_DN;
        for (int it = gw; it < NITEMS; it += NGW) {
            int r = it;
            if (r < I_IN) { const int kb = r / 160, nb = r % 160, d0 = 32 * nb; transpose_item(a.w_in, INCOLS, D, Win_t, 64 * kb, d0, d0 < NQKV ? d0 : d0 + 8, nullptr, scr, lane); continue; } r -= I_IN;
            if (r < I_BR) { const int kb = r / 32, nb = r % 32; transpose_item(a.wbsb, D, 512, Wbsb_t, 64 * kb, 32 * nb, 32 * nb, nullptr, scr, lane); continue; } r -= I_BR;
            if (r < I_BR) { const int kb = r / 32, nb = r % 32; transpose_item(a.wbfx, D, 512, Wbfx_t, 64 * kb, 32 * nb, 32 * nb, nullptr, scr, lane); continue; } r -= I_BR;
            if (r < I_OUT) { const int kb = r / 32, nb = r % 32; transpose_item(a.wout, D, D, Wout_t, 64 * kb, 32 * nb, 32 * nb, nullptr, scr, lane); continue; } r -= I_OUT;
            if (r < I_UP) { const int kb = r / 176, nb = r % 176, d0 = 32 * nb, pn = d0 >> 8, bj = (d0 >> 7) & 1, j = d0 & 127;
                transpose_item(a.wup, NUP, D, Wup_t, 64 * kb, d0, bj * DFF + 128 * pn + j, a.g2, scr, lane); continue; } r -= I_UP;
            { const int kb = r / 32, nb = r % 32; transpose_item(a.wdown, D, DFF, Wdn_t, 64 * kb, 32 * nb, 32 * nb, nullptr, scr, lane); }
        }
        __syncthreads();
        f32x4 gv[4];
#pragma unroll
        for (int j = 0; j < 4; ++j) gv[j] = ((const f32x4*)a.g1)[lane + 64 * j];
        for (int m = gw; m < M; m += NGW) {
            const int b = m / L, t = m - b * L;
            const f32x4* xr = (const f32x4*)((t < NMETA) ? a.meta + (size_t)t * D : a.x + ((size_t)b * SEQ + (t - NMETA)) * D) + lane;
            f32x4 v[4]; float s = 0.f;
#pragma unroll
            for (int j = 0; j < 4; ++j) { v[j] = xr[64 * j]; s += (v[j].x * v[j].x + v[j].y * v[j].y) + (v[j].z * v[j].z + v[j].w * v[j].w); }
            const float r = __builtin_amdgcn_rsqf(wave_sum(s) * (1.f / D) + EPS);
#pragma unroll
            for (int j = 0; j < 4; ++j) v[j] = v[j] * r * gv[j];
            u32x2* o8 = (u32x2*)(XN + (size_t)m * D) + lane;
#pragma unroll
            for (int j = 0; j < 4; ++j) { u32x2 w; w.x = cvtpk(v[j].x, v[j].y); w.y = cvtpk(v[j].z, v[j].w); o8[64 * j] = w; }
            float mine = 0.f;
#pragma unroll
            for (int jj = 0; jj < 8; ++jj) { float d = 0.f;
#pragma unroll
                for (int j = 0; j < 4; ++j) { const f32x4 w = *(const LAS f32x4*)(wfl + jj * 1024 + 4 * (lane + 64 * j)); d += (v[j].x * w.x + v[j].y * w.y) + (v[j].z * w.z + v[j].w * w.w); }
                d = wave_sum(d); if (lane == jj) mine = d; }
            if (lane < 8) fl[(size_t)m * 8 + lane] = mine;
        }
    }
    grid.sync();

    {
        pg8::Gemm g{XN, Win_t, D, D, 256, 0}; pg8::StaticOrder S; S.init(M / 256, NIN / 256, G, bx);
        pg8::EpiIn E{QKV, GT};
        pg8::gemm_phase<pg8::EpiIn>(lds, g, S, E);
        if (wave == 0) for (int seq = bx; seq < NB * 8; seq += G) { const int b = seq >> 3, h = seq & 7; const float bias = a.bf[h]; float carry = 0.f;
            for (int c = 0; c < (L + 63) / 64; ++c) { const int t = 64 * c + lane; float v = 0.f;
                if (t < L) { const float xx = fl[((size_t)b * L + t) * 8 + h] + bias; v = __builtin_fminf(xx, 0.f) * LOG2E - __builtin_amdgcn_logf(1.f + __builtin_amdgcn_exp2f(-__builtin_fabsf(xx) * LOG2E)); }
#pragma unroll
                for (int o = 1; o < 64; o <<= 1) { const float n = __shfl_up(v, o); if (lane >= o) v += n; }
                if (t < L) cum[(size_t)seq * L + t] = carry + v;
                carry += __shfl(v, 63); } }
    }
    grid.sync();

    for (int bh = bx; bh < NB * 8; bh += G) {
        const int b = bh >> 3, h = bh & 7;
        for (int jj = 0; jj < 9; ++jj) { const int j = 7 - jj; const bool mt = j < 0; att::unit<false>(QKV, nullptr, b, h, mt ? -16 : NMETA + 256 * j, mt ? 1 : 8, mt ? 1 : 4 * j + 5, lds); }
        for (int jj = 0; jj < 9; ++jj) { const int j = 7 - jj; const bool mt = j < 0; att::unit<true>(QKV, cum + (size_t)bh * L, b, h, mt ? -16 : NMETA + 256 * j, mt ? 1 : 8, mt ? 1 : 4 * j + 5, lds); }
    }
    grid.sync();

    {
        pg8::StaticOrder S; S.init(M / 256, D / 256, G, bx);
        { pg8::Gemm g{QKV, Wbsb_t, NQKV, 512, 256, 0}; pg8::EpiBr<0> E{GT, MG}; pg8::gemm_phase<pg8::EpiBr<0>>(lds, g, S, E); }
        { pg8::Gemm g{QKV + 1536, Wbfx_t, NQKV, 512, 256, 0}; pg8::EpiBr<1> E{GT, MG}; pg8::gemm_phase<pg8::EpiBr<1>>(lds, g, S, E); }
    }
    grid.sync();

    {
        pg8::Gemm g{MG, Wout_t, D, D, 256, 0}; pg8::StaticOrder S; S.init(M / 256, D / 256, G, bx);
        pg8::EpiOut E{a.x, a.meta, a.out, metah, H1B, ss1};
        pg8::gemm_phase<pg8::EpiOut>(lds, g, S, E);
    }
    grid.sync();

    {
        pg8::Gemm g{H1B, Wup_t, D, D, 254, -2}; pg8::StaticOrder S; S.init(261, NUP / 256, G, bx);
        pg8::EpiUp E{ss1, a.convw, ACT, (LAS float*)(lds + pg8::STAGE_BYTES)};
        pg8::gemm_phase<pg8::EpiUp>(lds, g, S, E);
    }
    grid.sync();

    {
        pg8::Gemm g{ACT, Wdn_t, DFF, DFF, 256, 0}; pg8::StaticOrder S; S.init(M / 256, D / 256, G, bx);
        pg8::EpiDown E{a.out, ss2};
        pg8::gemm_phase<pg8::EpiDown>(lds, g, S, E);
    }
    grid.sync();

    {
        f32x4 gv[4];
#pragma unroll
        for (int j = 0; j < 4; ++j) gv[j] = ((const f32x4*)a.gf)[lane + 64 * j];
        for (int m = gw; m < NB * SEQ; m += NGW) {
            const float r = __builtin_amdgcn_rsqf(ss2[m] * (1.f / D) + EPS);
            f32x4* p = (f32x4*)(a.out + (size_t)m * D) + lane;
#pragma unroll
            for (int j = 0; j < 4; ++j) p[64 * j] = p[64 * j] * r * gv[j];
        }
    }
}

extern "C" void kernel_launch(void* const* d_in, const int* in_sizes, int n_in, void* d_out, int out_size, void* d_ws, size_t ws_size, hipStream_t stream) {
    static int grid = 0;
    if (grid == 0) {
        if (n_in != 13 || out_size != NB * SEQ * D || ws_size < WS_END) { fprintf(stderr, "kernel_launch: unexpected shapes (n_in %d out %d ws %zu)\n", n_in, out_size, ws_size); grid = -1; return; }
        int dev = 0, cus = 0, per_cu = 0;
        (void)hipGetDevice(&dev);
        (void)hipDeviceGetAttribute(&cus, hipDeviceAttributeMultiprocessorCount, dev);
        (void)hipFuncSetAttribute((const void*)fwd_mega, hipFuncAttributeMaxDynamicSharedMemorySize, LDS_BYTES);
        (void)hipOccupancyMaxActiveBlocksPerMultiprocessor(&per_cu, (const void*)fwd_mega, 512, LDS_BYTES);
        if (per_cu < 1) per_cu = 1;
        grid = cus * per_cu;
    }
    if (grid < 0) return;
    Args a{};
    a.x = (const float*)d_in[0]; a.meta = (const float*)d_in[1]; a.g1 = (const float*)d_in[2]; a.w_in = (const float*)d_in[3]; a.bf = (const float*)d_in[4];
    a.wbsb = (const float*)d_in[5]; a.wbfx = (const float*)d_in[6]; a.wout = (const float*)d_in[7]; a.g2 = (const float*)d_in[8]; a.wup = (const float*)d_in[9];
    a.convw = (const float*)d_in[10]; a.wdown = (const float*)d_in[11]; a.gf = (const float*)d_in[12]; a.out = (float*)d_out; a.ws = (unsigned char*)d_ws;
    void* args[] = {&a};
    hipError_t e = hipLaunchCooperativeKernel((const void*)fwd_mega, dim3(grid), dim3(512), args, LDS_BYTES, stream);
    if (e != hipSuccess) fprintf(stderr, "cooperative launch failed: %s (grid %d)\n", hipGetErrorString(e), grid);
}
```

```cpp
#include <hip/hip_runtime.h>
#include <hip/hip_cooperative_groups.h>
#include <cstdio>
#include <cstdint>
namespace cg = cooperative_groups;

#define LAS __attribute__((address_space(3)))
typedef unsigned short bf16_t;
typedef short bf16x8 __attribute__((ext_vector_type(8)));
typedef short s16x4 __attribute__((ext_vector_type(4)));
typedef float f32x2 __attribute__((ext_vector_type(2)));
typedef float f32x4 __attribute__((ext_vector_type(4)));
typedef float f32x16 __attribute__((ext_vector_type(16)));
typedef unsigned u32x2 __attribute__((ext_vector_type(2)));
typedef unsigned u32x4 __attribute__((ext_vector_type(4)));
typedef __bf16 bf16x2_t __attribute__((ext_vector_type(2)));

constexpr int NB = 32, SEQ = 2048, NMETA = 16, L = SEQ + NMETA, D = 1024, M = NB * L, DFF = 2816;
constexpr int NQKV = 3072, NGATE = 2048, NIN = 5120, INCOLS = 5128, NUP = 2 * DFF;
constexpr float EPS = 1e-6f, LOG2E = 1.4426950408889634f, C2 = 0.125f * LOG2E;
static_assert(M % 256 == 0, "M tiles");

constexpr size_t MiB = 1u << 20;
constexpr size_t WS_BAR = 800 * 1024, WS_BAR_BYTES = 16384;
constexpr size_t WS_SS1 = 0, WS_SS2 = 512 * 1024, WS_FL = 1 * MiB, WS_CUM = 4 * MiB, WS_METAH = 7 * MiB;
constexpr size_t WS_WIN = 10 * MiB, WS_WBSB = 20 * MiB, WS_WBFX = 21 * MiB, WS_WOUT = 22 * MiB, WS_WUP = 24 * MiB, WS_WDN = 35 * MiB;
constexpr size_t WS_XN = 42 * MiB;
constexpr size_t WS_QKV = 172 * MiB;
constexpr size_t WS_G = 560 * MiB;
constexpr size_t WS_O = 820 * MiB;
constexpr size_t WS_END = 950 * MiB;

__device__ __forceinline__ unsigned cvtpk(float lo, float hi) { f32x2 v = {lo, hi}; bf16x2_t b = __builtin_convertvector(v, bf16x2_t); return __builtin_bit_cast(unsigned, b); }
__device__ __forceinline__ float bflo(unsigned u) { return __uint_as_float(u << 16); }
__device__ __forceinline__ float bfhi(unsigned u) { return __uint_as_float(u & 0xffff0000u); }
__device__ __forceinline__ float sigmoid_(float x) { return __builtin_amdgcn_rcpf(1.f + __builtin_amdgcn_exp2f(-LOG2E * x)); }
__device__ __forceinline__ float wave_sum(float v) {
#pragma unroll
    for (int o = 1; o < 64; o <<= 1) v += __shfl_xor(v, o);
    return v;
}

namespace pg8 {
constexpr int BM = 256, BK = 64, HALF = 128, HTB = HALF * BK * 2, STAGE_BYTES = 8 * HTB, NXCD = 8, WGM = 8;
__host__ __device__ __forceinline__ int lds_byte(int r, int c) { const int st = (r >> 4) * 2 + (c >> 5), rr = r & 15, cc = c & 31, ob = rr * 64 + cc * 2; return st * 1024 + (ob ^ (((ob >> 9) & 1) << 5)); }
__host__ __device__ __forceinline__ void stage_rc(int b, int& R, int& C) { const int st = b / 1024, sb = b % 1024, swz = sb ^ (((sb >> 9) & 1) << 5); R = (st >> 1) * 16 + swz / 64; C = (st & 1) * 32 + (swz % 64) / 2; }
__host__ __device__ __forceinline__ int perm32(int rho) { const int n = rho >> 4, i = rho & 15; return 8 * (i >> 2) + 4 * n + (i & 3); }

struct Unit { int pm, pn; };
struct Gemm { const bf16_t* A; const bf16_t* Bt; int lda, K, mstep, moff; };

struct StaticOrder {
    int nM, nN, nwg, G, c;
    __device__ void init(int nM_, int nN_, int G_, int c_) { nM = nM_; nN = nN_; nwg = nM * nN; G = G_; c = c_; }
    __device__ bool next(int i, Unit& u) const {
        const long Lx = (long)i * G + c; if (Lx >= nwg) return false;
        int wgid = (int)Lx; { const int q = nwg / NXCD, r = nwg % NXCD, xcd = wgid % NXCD, off = wgid / NXCD; wgid = (xcd < r ? xcd * (q + 1) : r * (q + 1) + (xcd - r) * q) + off; }
        const int nig = WGM * nN, gid = wgid / nig, fm = gid * WGM, gsz = (nM - fm) < WGM ? (nM - fm) : WGM;
        u.pm = fm + ((wgid % nig) % gsz); u.pn = (wgid % nig) / gsz; return true;
    }
};

template <class Epi>
__device__ __forceinline__ void gemm_phase(LAS unsigned char* lds, const Gemm g, const StaticOrder& S, const Epi& E) {
    const int tid = threadIdx.x, wid = __builtin_amdgcn_readfirstlane(tid >> 6), lane = tid & 63, wr = wid >> 2, wc = wid & 3, fr = lane & 15, fq = lane >> 4;
    const int K = g.K, nt = K / BK, lda = g.lda;
    unsigned voffA[2], voffB[2];
#pragma unroll
    for (int i = 0; i < 2; ++i) { int R, C; stage_rc(tid * 16 + i * 8192, R, C); const int Rb = (R & ~31) + perm32(R & 31);
        voffA[i] = (unsigned)(R * lda + C) * 2u; voffB[i] = (unsigned)(Rb * K + C) * 2u; }
    const size_t kstep = (size_t)(BK * 2);
    const size_t hstA = (size_t)HALF * lda * 2, hstB = (size_t)HALF * K * 2;
    const unsigned ldsw = (unsigned)wid * 1024u;
    const int aoff = lds_byte(wr * 64 + fr, fq * 8), boff = lds_byte(wc * 32 + fr, fq * 8);
#define PG8_SA(b, h) (((b) * 2 + (h)) * HTB)
#define PG8_SB(b, h) ((4 + (b) * 2 + (h)) * HTB)
#define PG8_STAGE(bufoff, gbase, voff) do { _Pragma("unroll") for (int _i = 0; _i < 2; ++_i) \
        __builtin_amdgcn_global_load_lds((const unsigned*)((const char*)(gbase) + (voff)[_i]), (LAS unsigned*)(lds + (bufoff) + ldsw + _i * 8192), 16, 0, 0); } while (0)
#define PG8_LDA(dst, b, h) do { _Pragma("unroll") for (int m = 0; m < 4; ++m) _Pragma("unroll") for (int k = 0; k < 2; ++k) dst[m][k] = *(const LAS bf16x8*)(lds + PG8_SA(b, h) + aoff + m * 2048 + k * 1024); } while (0)
#define PG8_LDB(dst, b, h) do { _Pragma("unroll") for (int n = 0; n < 2; ++n) _Pragma("unroll") for (int k = 0; k < 2; ++k) dst[n][k] = *(const LAS bf16x8*)(lds + PG8_SB(b, h) + boff + n * 2048 + k * 1024); } while (0)
#define PG8_MMA(ai, bj, At, Bt) do { __builtin_amdgcn_s_setprio(1); _Pragma("unroll") for (int m = 0; m < 4; ++m) _Pragma("unroll") for (int n = 0; n < 2; ++n) _Pragma("unroll") for (int k = 0; k < 2; ++k) \
        acc[ai][bj][m][n] = __builtin_amdgcn_mfma_f32_16x16x32_bf16(Bt[n][k], At[m][k], acc[ai][bj][m][n], 0, 0, 0); __builtin_amdgcn_s_setprio(0); } while (0)
#define PG8_WAIT_V(n) asm volatile("s_waitcnt vmcnt(" #n ")" ::: "memory")
#define PG8_WAIT_L(n) asm volatile("s_waitcnt lgkmcnt(" #n ")" ::: "memory")
#define PG8_BAR __builtin_amdgcn_s_barrier()
#define PG8_SCHED __builtin_amdgcn_sched_barrier(0)
    Unit cur, nxt; int ui = 0;
    if (!S.next(0, cur)) return;
    f32x4 acc[2][2][4][2];
#pragma unroll
    for (int a = 0; a < 2; ++a)
#pragma unroll
        for (int b = 0; b < 2; ++b)
#pragma unroll
            for (int m = 0; m < 4; ++m)
#pragma unroll
                for (int n = 0; n < 2; ++n) acc[a][b][m][n] = (f32x4){0.f, 0.f, 0.f, 0.f};
    bf16x8 At[4][2], B0[2][2], B1[2][2];
    const char* cA = (const char*)g.A + ((long)cur.pm * g.mstep + g.moff) * (long)lda * 2; const char* cB = (const char*)g.Bt + (size_t)cur.pn * 2 * hstB;
    PG8_STAGE(PG8_SB(0, 0), cB, voffB); PG8_STAGE(PG8_SB(0, 1), cB + hstB, voffB); PG8_STAGE(PG8_SA(0, 0), cA, voffA); PG8_STAGE(PG8_SA(0, 1), cA + hstA, voffA);
    if (wr == 1) PG8_BAR;
    PG8_WAIT_V(2); PG8_BAR;
    PG8_STAGE(PG8_SB(1, 0), cB + kstep, voffB); PG8_STAGE(PG8_SA(1, 0), cA + kstep, voffA); PG8_STAGE(PG8_SB(1, 1), cB + hstB + kstep, voffB);
    PG8_WAIT_V(6); PG8_BAR;
    for (;;) {
        const bool has_next = S.next(ui + 1, nxt);
        const char* nA = has_next ? (const char*)g.A + ((long)nxt.pm * g.mstep + g.moff) * (long)lda * 2 : cA; const char* nB = has_next ? (const char*)g.Bt + (size_t)nxt.pn * 2 * hstB : cB;
        for (int t = 0; t < nt; t += 2) {
            const bool last = (t == nt - 2);
            const char* a1 = cA + (size_t)(t + 1) * kstep;
            const char* a2 = last ? nA : cA + (size_t)(t + 2) * kstep; const char* b2 = last ? nB : cB + (size_t)(t + 2) * kstep;
            const char* a3 = a2 + kstep; const char* b3 = b2 + kstep;
            PG8_LDB(B0, 0, 0); PG8_LDB(B1, 0, 1); PG8_SCHED; PG8_LDA(At, 0, 0); PG8_STAGE(PG8_SA(1, 1), a1 + hstA, voffA);
            PG8_WAIT_V(8); PG8_WAIT_L(0); PG8_BAR; PG8_MMA(0, 0, At, B0); PG8_MMA(0, 1, At, B1); PG8_BAR; PG8_SCHED;
            PG8_LDA(At, 0, 1); PG8_STAGE(PG8_SB(0, 0), b2, voffB); PG8_STAGE(PG8_SB(0, 1), b2 + hstB, voffB); PG8_STAGE(PG8_SA(0, 0), a2, voffA);
            PG8_WAIT_V(8); PG8_WAIT_L(0); PG8_BAR; PG8_MMA(1, 0, At, B0); PG8_MMA(1, 1, At, B1); PG8_BAR; PG8_SCHED;
            PG8_LDB(B0, 1, 0); PG8_LDB(B1, 1, 1); PG8_SCHED; PG8_LDA(At, 1, 0); PG8_STAGE(PG8_SA(0, 1), a2 + hstA, voffA);
            PG8_WAIT_V(8); PG8_WAIT_L(0); PG8_BAR; PG8_MMA(0, 0, At, B0); PG8_MMA(0, 1, At, B1); PG8_BAR; PG8_SCHED;
            PG8_LDA(At, 1, 1); PG8_STAGE(PG8_SB(1, 0), b3, voffB); PG8_STAGE(PG8_SB(1, 1), b3 + hstB, voffB); PG8_STAGE(PG8_SA(1, 0), a3, voffA);
            PG8_WAIT_V(8); PG8_WAIT_L(0); PG8_BAR; PG8_MMA(1, 0, At, B0); PG8_MMA(1, 1, At, B1); PG8_BAR; PG8_SCHED;
        }
        if (wr == 0) PG8_BAR;
        E(acc, cur, wr, wc, fr, fq);
        if (!has_next) break;
#pragma unroll
        for (int a = 0; a < 2; ++a)
#pragma unroll
            for (int b = 0; b < 2; ++b)
#pragma unroll
                for (int m = 0; m < 4; ++m)
#pragma unroll
                    for (int n = 0; n < 2; ++n) acc[a][b][m][n] = (f32x4){0.f, 0.f, 0.f, 0.f};
        cur = nxt; cA = nA; cB = nB; ++ui;
        if (wr == 1) PG8_BAR;
    }
    PG8_WAIT_V(0);
    PG8_BAR;
#undef PG8_SA
#undef PG8_SB
#undef PG8_STAGE
#undef PG8_LDA
#undef PG8_LDB
#undef PG8_MMA
}

typedef f32x4 Acc[2][2][4][2];
struct EpiIn {
    bf16_t* QKV; bf16_t* G;
    __device__ __forceinline__ void operator()(const Acc& acc, const Unit& u, int wr, int wc, int fr, int fq) const {
        const int row0 = u.pm * BM + wr * 64 + fr; const bool gate = u.pn >= 12;
        bf16_t* base; int ldc; float sc = 1.f;
        if (!gate) { base = QKV + u.pn * 256; ldc = NQKV; if (u.pn == 0 || u.pn == 1 || u.pn == 6 || u.pn == 7) sc = C2; } else { base = G + (u.pn - 12) * 256; ldc = NGATE; }
        const int col0 = wc * 32 + 8 * fq;
#pragma unroll
        for (int ai = 0; ai < 2; ++ai)
#pragma unroll
            for (int m = 0; m < 4; ++m) { bf16_t* rowp = base + (size_t)(row0 + ai * HALF + m * 16) * ldc + col0;
#pragma unroll
                for (int bj = 0; bj < 2; ++bj) { f32x4 v0 = acc[ai][bj][m][0], v1 = acc[ai][bj][m][1];
                    if (gate) {
#pragma unroll
                        for (int j = 0; j < 4; ++j) { v0[j] = sigmoid_(v0[j]); v1[j] = sigmoid_(v1[j]); } }
                    else { v0 = v0 * sc; v1 = v1 * sc; }
                    u32x4 w; w.x = cvtpk(v0[0], v0[1]); w.y = cvtpk(v0[2], v0[3]); w.z = cvtpk(v1[0], v1[1]); w.w = cvtpk(v1[2], v1[3]);
                    *(u32x4*)(rowp + bj * HALF) = w; } }
    }
};
template <int PASS> struct EpiBr {
    const bf16_t* G; bf16_t* MG;
    __device__ __forceinline__ void operator()(const Acc& acc, const Unit& u, int wr, int wc, int fr, int fq) const {
        const int row0 = u.pm * BM + wr * 64 + fr, col0 = u.pn * BM + wc * 32 + 8 * fq;
#pragma unroll
        for (int ai = 0; ai < 2; ++ai)
#pragma unroll
            for (int m = 0; m < 4; ++m) { const size_t row = (size_t)(row0 + ai * HALF + m * 16);
                const bf16_t* gp = G + row * NGATE + PASS * 1024 + col0; bf16_t* mp = MG + row * D + col0;
#pragma unroll
                for (int bj = 0; bj < 2; ++bj) { const u32x4 gv = *(const u32x4*)(gp + bj * HALF); f32x4 v0 = acc[ai][bj][m][0], v1 = acc[ai][bj][m][1];
                    v0[0] *= bflo(gv.x); v0[1] *= bfhi(gv.x); v0[2] *= bflo(gv.y); v0[3] *= bfhi(gv.y); v1[0] *= bflo(gv.z); v1[1] *= bfhi(gv.z); v1[2] *= bflo(gv.w); v1[3] *= bfhi(gv.w);
                    if (PASS == 1) { const u32x4 tv = *(const u32x4*)(mp + bj * HALF);
                        v0[0] += bflo(tv.x); v0[1] += bfhi(tv.x); v0[2] += bflo(tv.y); v0[3] += bfhi(tv.y); v1[0] += bflo(tv.z); v1[1] += bfhi(tv.z); v1[2] += bflo(tv.w); v1[3] += bfhi(tv.w); }
                    u32x4 w; w.x = cvtpk(v0[0], v0[1]); w.y = cvtpk(v0[2], v0[3]); w.z = cvtpk(v1[0], v1[1]); w.w = cvtpk(v1[2], v1[3]);
                    *(u32x4*)(mp + bj * HALF) = w; } }
    }
};
struct EpiOut {
    const float* x; const float* meta; float* out; float* metah; bf16_t* H1B; float* ss1;
    __device__ __forceinline__ void operator()(const Acc& acc, const Unit& u, int wr, int wc, int fr, int fq) const {
        const int row0 = u.pm * BM + wr * 64 + fr, col0 = u.pn * BM + wc * 32 + 8 * fq;
#pragma unroll
        for (int ai = 0; ai < 2; ++ai)
#pragma unroll
            for (int m = 0; m < 4; ++m) { const int row = row0 + ai * HALF + m * 16; const int b = row / L, t = row - b * L;
                const float* hs = (t < NMETA) ? meta + (size_t)t * D : x + ((size_t)b * SEQ + (t - NMETA)) * D;
                float* hd = (t < NMETA) ? metah + ((size_t)b * NMETA + t) * D : out + ((size_t)b * SEQ + (t - NMETA)) * D;
                float ss = 0.f;
#pragma unroll
                for (int bj = 0; bj < 2; ++bj) { const int c = col0 + bj * HALF;
                    const f32x4 h0 = *(const f32x4*)(hs + c), h1 = *(const f32x4*)(hs + c + 4);
                    const f32x4 v0 = acc[ai][bj][m][0] + h0, v1 = acc[ai][bj][m][1] + h1;
                    *(f32x4*)(hd + c) = v0; *(f32x4*)(hd + c + 4) = v1;
                    ss += (v0[0] * v0[0] + v0[1] * v0[1]) + (v0[2] * v0[2] + v0[3] * v0[3]) + (v1[0] * v1[0] + v1[1] * v1[1]) + (v1[2] * v1[2] + v1[3] * v1[3]);
                    u32x4 w; w.x = cvtpk(v0[0], v0[1]); w.y = cvtpk(v0[2], v0[3]); w.z = cvtpk(v1[0], v1[1]); w.w = cvtpk(v1[2], v1[3]);
                    *(u32x4*)(H1B + (size_t)row * D + c) = w; }
                ss += __shfl_xor(ss, 16); ss += __shfl_xor(ss, 32);
                if (fq == 0) unsafeAtomicAdd(ss1 + row, ss); }
    }
};
__device__ __forceinline__ float fmac_ror1(float acc, float x, float c) { asm("s_nop 1\n\tv_fmac_f32_dpp %0, %1, %2 row_ror:1 row_mask:0xf bank_mask:0xf" : "+v"(acc) : "v"(x), "v"(c)); return acc; }
__device__ __forceinline__ float fmac_ror2(float acc, float x, float c) { asm("s_nop 1\n\tv_fmac_f32_dpp %0, %1, %2 row_ror:2 row_mask:0xf bank_mask:0xf" : "+v"(acc) : "v"(x), "v"(c)); return acc; }
struct EpiUp {
    const float* ss1; const float* convw; bf16_t* ACT; LAS float* halo;
    __device__ __forceinline__ void operator()(Acc& acc, const Unit& u, int wr, int wc, int fr, int fq) const {
        const int R0 = 254 * u.pm - 2;
        unsigned ok1 = 0, ok2 = 0, okst = 0;
#pragma unroll
        for (int ai = 0; ai < 2; ++ai)
#pragma unroll
            for (int m = 0; m < 4; ++m) { const int lr = ai * HALF + wr * 64 + m * 16 + fr, grow = R0 + lr; const bool inr = grow >= 0 && grow < M;
                const float r2 = inr ? __builtin_amdgcn_rsqf(ss1[inr ? grow : 0] * (1.f / D) + EPS) : 0.f;
                const int t = inr ? grow % L : 0;
                if (t >= 1) ok1 |= 1u << (ai * 4 + m); if (t >= 2) ok2 |= 1u << (ai * 4 + m); if (inr && lr >= 2 && t >= NMETA) okst |= 1u << (ai * 4 + m);
#pragma unroll
                for (int bj = 0; bj < 2; ++bj)
#pragma unroll
                    for (int n = 0; n < 2; ++n) acc[ai][bj][m][n] = acc[ai][bj][m][n] * r2; }
        if (fr >= 14) {
#pragma unroll
            for (int ai = 0; ai < 2; ++ai)
#pragma unroll
                for (int bj = 0; bj < 2; ++bj)
#pragma unroll
                    for (int n = 0; n < 2; ++n) *(LAS f32x4*)(halo + ((ai * 2 + wr) * 2 + (fr - 14)) * 256 + bj * HALF + wc * 32 + 8 * fq + 4 * n) = acc[ai][bj][3][n];
        }
        asm volatile("s_waitcnt lgkmcnt(0)" ::: "memory"); __builtin_amdgcn_s_barrier(); asm volatile("" ::: "memory");
        const int chn = u.pn * 128 + wc * 32 + 8 * fq;
#pragma unroll
        for (int bj = 0; bj < 2; ++bj)
#pragma unroll
            for (int n = 0; n < 2; ++n) {
                asm volatile("" ::: "memory");
                const f32x4 c0 = *(const f32x4*)(convw + (size_t)0 * NUP + bj * DFF + chn + 4 * n), c1 = *(const f32x4*)(convw + (size_t)1 * NUP + bj * DFF + chn + 4 * n), c2 = *(const f32x4*)(convw + (size_t)2 * NUP + bj * DFF + chn + 4 * n);
#pragma unroll
                for (int ai = 0; ai < 2; ++ai) {
                    const int idx = ai * 2 + wr;
                    const f32x4 hreg = (idx > 0) ? *(const LAS f32x4*)(halo + ((idx - 1) * 2 + (fr == 15 ? 1 : 0)) * 256 + bj * HALF + wc * 32 + 8 * fq + 4 * n) : (f32x4){0.f, 0.f, 0.f, 0.f};
#pragma unroll
                    for (int m = 3; m >= 0; --m) {
                        const bool t1 = (ok1 >> (ai * 4 + m)) & 1u, t2 = (ok2 >> (ai * 4 + m)) & 1u;
                        const f32x4 cu = acc[ai][bj][m][n]; const f32x4 pv = (m > 0) ? acc[ai][bj][m > 0 ? m - 1 : 0][n] : hreg; f32x4 uc;
#pragma unroll
                        for (int j = 0; j < 4; ++j) { const float x1 = (fr == 15) ? pv[j] : cu[j], x2 = (fr >= 14) ? pv[j] : cu[j];
                            const float c1m = t1 ? c1[j] : 0.f, c0m = t2 ? c0[j] : 0.f;
                            uc[j] = fmac_ror2(fmac_ror1(c2[j] * cu[j], x1, c1m), x2, c0m); }
                        acc[ai][bj][m][n] = uc;
                    }
                }
                asm volatile("" ::: "memory"); __builtin_amdgcn_sched_barrier(0);
            }
#pragma unroll
        for (int ai = 0; ai < 2; ++ai)
#pragma unroll
            for (int m = 0; m < 4; ++m) {
                const f32x4 a0 = acc[ai][0][m][0], a1 = acc[ai][0][m][1], b0 = acc[ai][1][m][0], b1 = acc[ai][1][m][1];
                float v[8];
#pragma unroll
                for (int j = 0; j < 4; ++j) { v[j] = a0[j] * sigmoid_(a0[j]) * b0[j]; v[4 + j] = a1[j] * sigmoid_(a1[j]) * b1[j]; }
                if ((okst >> (ai * 4 + m)) & 1u) { u32x4 w; w.x = cvtpk(v[0], v[1]); w.y = cvtpk(v[2], v[3]); w.z = cvtpk(v[4], v[5]); w.w = cvtpk(v[6], v[7]);
                    const int grow = R0 + ai * HALF + wr * 64 + m * 16 + fr, bb = grow / L, arow = grow - bb * L - NMETA + bb * SEQ; *(u32x4*)(ACT + (size_t)arow * DFF + chn) = w; }
                __builtin_amdgcn_sched_barrier(0);
            }
    }
};
struct EpiDown {
    float* out; float* ss2;
    __device__ __forceinline__ void operator()(const Acc& acc, const Unit& u, int wr, int wc, int fr, int fq) const {
        const int row0 = u.pm * BM + wr * 64 + fr, col0 = u.pn * BM + wc * 32 + 8 * fq;
#pragma unroll
        for (int ai = 0; ai < 2; ++ai)
#pragma unroll
            for (int m = 0; m < 4; ++m) { const int row = row0 + ai * HALF + m * 16; float* hd = out + (size_t)row * D; float ss = 0.f;
#pragma unroll
                for (int bj = 0; bj < 2; ++bj) { const int c = col0 + bj * HALF;
                    const f32x4 h0 = *(const f32x4*)(hd + c), h1 = *(const f32x4*)(hd + c + 4);
                    const f32x4 v0 = acc[ai][bj][m][0] + h0, v1 = acc[ai][bj][m][1] + h1;
                    *(f32x4*)(hd + c) = v0; *(f32x4*)(hd + c + 4) = v1;
                    ss += (v0[0] * v0[0] + v0[1] * v0[1]) + (v0[2] * v0[2] + v0[3] * v0[3]) + (v1[0] * v1[0] + v1[1] * v1[1]) + (v1[2] * v1[2] + v1[3] * v1[3]); }
                ss += __shfl_xor(ss, 16); ss += __shfl_xor(ss, 32);
                if (fq == 0) unsafeAtomicAdd(ss2 + row, ss); }
    }
};
}

namespace att {
constexpr int SLOT = 16384, LDS_KB = 2 * SLOT;
__device__ __forceinline__ int crow(int r, int hi) { return (r & 3) + 8 * (r >> 2) + 4 * hi; }
__device__ __forceinline__ s16x4 vtr(const LAS unsigned char* p) { return __builtin_bit_cast(s16x4, __builtin_amdgcn_ds_read_tr16_b64_v4i16((LAS s16x4*)p)); }

template <bool FOX>
__device__ __forceinline__ void unit(const bf16_t* QKV, bf16_t* O, const float* cum, int b, int h, int qt0, int nact, int NT, LAS unsigned char* lds) {
    const int tid = threadIdx.x, lane = tid & 63, r32 = lane & 31, hi = lane >> 5; const int wid = __builtin_amdgcn_readfirstlane(tid >> 6);
    const long rowbase = (long)b * L; const int colq = (FOX ? 1536 : 0) + h * 64, colk = colq + 512, colv = colq + 1024;
    const int tw0 = qt0 + 32 * wid, tq = tw0 + r32;
    LAS float* kbs = (LAS float*)(lds + LDS_KB);
    if (FOX) { for (int p = tid; p < 64 * NT; p += 512) { const int t = p - 48; kbs[p] = (t >= 0 && t < L) ? -cum[t] : 0.f; } }
    const int kkK = lane, kkV = 16 * (wid & 3) + (lane >> 2);
    const bf16_t* kcol = QKV + colk + wid * 8; const bf16_t* vcol = QKV + colv + (wid >> 2) * 32 + (lane & 3) * 8;
#define ATT_ISSUE(i, slot) do { const int tk_ = 64 * (i) - 48; int ta_ = tk_ + kkK; ta_ = ta_ < 0 ? 0 : ta_; int tb_ = tk_ + kkV; tb_ = tb_ < 0 ? 0 : tb_; \
        __builtin_amdgcn_global_load_lds((const unsigned*)(kcol + (rowbase + ta_) * NQKV), (LAS unsigned*)(lds + (slot) * SLOT + wid * 1024), 16, 0, 0); \
        __builtin_amdgcn_global_load_lds((const unsigned*)(vcol + (rowbase + tb_) * NQKV), (LAS unsigned*)(lds + (slot) * SLOT + 8192 + wid * 1024), 16, 0, 0); } while (0)
    ATT_ISSUE(FOX ? 0 : NT - 1, 0);
    bf16x8 qr[4];
    { const int tqc = tq < 0 ? 0 : tq; const bf16_t* qp = QKV + (rowbase + tqc) * NQKV + colq + hi * 8;
#pragma unroll
      for (int d0 = 0; d0 < 4; ++d0) qr[d0] = *(const bf16x8*)(qp + d0 * 16); }
    f32x16 o[2]; o[0] = f32x16{}; o[1] = f32x16{};
    float mref = 0.f, lsum = 0.f, carry = 0.f;
    const float him = hi == 0 ? 1.f : 0.f;
    asm volatile("s_waitcnt vmcnt(0) lgkmcnt(0)\n\ts_barrier" ::: "memory");
    for (int s = 0; s < NT; ++s) {
        const int i = FOX ? s : NT - 1 - s;
        if (s + 1 < NT) ATT_ISSUE(FOX ? s + 1 : NT - 2 - s, (s + 1) & 1);
        const int tk0 = 64 * i - 48;
        const bool skip = FOX ? (tk0 > tw0 + 31) : (tk0 >= tw0 + 31);
        if (wid < nact && !skip) {
            const LAS unsigned char* Ks = lds + (s & 1) * SLOT; const LAS unsigned char* Vs = Ks + 8192;
            const bool needmask = (i == 0) || (tk0 + 63 >= tw0);
            f32x16 p0, p1;
            if (FOX) {
#pragma unroll
                for (int g = 0; g < 4; ++g) { const f32x4 a = *(const LAS f32x4*)(kbs + 64 * i + 4 * hi + 8 * g), c = *(const LAS f32x4*)(kbs + 64 * i + 32 + 4 * hi + 8 * g);
#pragma unroll
                    for (int j = 0; j < 4; ++j) { p0[4 * g + j] = a[j] - mref; p1[4 * g + j] = c[j] - mref; } }
            } else { p0 = f32x16{}; p1 = f32x16{}; }
            const LAS unsigned char* kp = Ks + hi * 1024 + r32 * 16;
#pragma unroll
            for (int d0 = 0; d0 < 4; ++d0) { const bf16x8 a0 = *(const LAS bf16x8*)(kp + d0 * 2048), a1 = *(const LAS bf16x8*)(kp + d0 * 2048 + 512);
                p0 = __builtin_amdgcn_mfma_f32_32x32x16_bf16(a0, qr[d0], p0, 0, 0, 0); p1 = __builtin_amdgcn_mfma_f32_32x32x16_bf16(a1, qr[d0], p1, 0, 0, 0); }
            if (FOX) {
                if (needmask) {
#pragma unroll
                    for (int r = 0; r < 16; ++r) { const int tk = tk0 + crow(r, hi); if (!(tk >= 0 && tk <= tq)) p0[r] = -1e30f; if (!(tk + 32 >= 0 && tk + 32 <= tq)) p1[r] = -1e30f; } }
                float rm = p0[0];
#pragma unroll
                for (int r = 1; r < 16; ++r) rm = __builtin_fmaxf(rm, p0[r]);
#pragma unroll
                for (int r = 0; r < 16; ++r) rm = __builtin_fmaxf(rm, p1[r]);
                { auto rr = __builtin_amdgcn_permlane32_swap(__float_as_uint(rm), __float_as_uint(rm), false, false); rm = __builtin_fmaxf(__uint_as_float(rr[0]), __uint_as_float(rr[1])); }
                if (s == 0 || __any(rm > 8.f)) {
                    const float dl = (s == 0) ? rm : __builtin_fmaxf(rm, 0.f); mref += dl;
                    const float f = __builtin_amdgcn_exp2f(-dl); lsum *= f;
#pragma unroll
                    for (int r = 0; r < 16; ++r) { p0[r] -= dl; p1[r] -= dl; o[0][r] *= f; o[1][r] *= f; } }
                float sacc = 0.f;
#pragma unroll
                for (int r = 0; r < 16; ++r) { p0[r] = __builtin_amdgcn_exp2f(p0[r]); p1[r] = __builtin_amdgcn_exp2f(p1[r]); sacc += p0[r] + p1[r]; }
                lsum += sacc;
            } else {
                f32x16 s0, s1;
#pragma unroll
                for (int r = 0; r < 16; ++r) { const float z0 = __builtin_fminf(p0[r], 80.f), z1 = __builtin_fminf(p1[r], 80.f);
                    s0[r] = __builtin_amdgcn_logf(1.f + __builtin_amdgcn_exp2f(z0)); s1[r] = __builtin_amdgcn_logf(1.f + __builtin_amdgcn_exp2f(z1));
                    p0[r] = z0 - s0[r]; p1[r] = z1 - s1[r]; }
                if (needmask) {
#pragma unroll
                    for (int r = 0; r < 16; ++r) { const int tk = tk0 + crow(r, hi); const bool v0 = tk >= 0 && tk < tq, v1 = tk + 32 >= 0 && tk + 32 < tq;
                        s0[r] = v0 ? s0[r] : 0.f; p0[r] = v0 ? p0[r] : -1e30f; s1[r] = v1 ? s1[r] : 0.f; p1[r] = v1 ? p1[r] : -1e30f; } }
                float run = carry;
#pragma unroll
                for (int hf = 1; hf >= 0; --hf)
#pragma unroll
                    for (int g = 3; g >= 0; --g) {
                        f32x16& sp = hf ? s1 : s0; f32x16& pp = hf ? p1 : p0;
                        const float a2 = sp[4 * g + 3], a1 = a2 + sp[4 * g + 2], a0 = a1 + sp[4 * g + 1], G = a0 + sp[4 * g];
                        auto rr = __builtin_amdgcn_permlane32_swap(__float_as_uint(G), __float_as_uint(G), false, false);
                        const float base = run + him * __uint_as_float(rr[1]);
                        pp[4 * g + 3] = __builtin_amdgcn_exp2f(pp[4 * g + 3] - base); pp[4 * g + 2] = __builtin_amdgcn_exp2f(pp[4 * g + 2] - (base + a2));
                        pp[4 * g + 1] = __builtin_amdgcn_exp2f(pp[4 * g + 1] - (base + a1)); pp[4 * g] = __builtin_amdgcn_exp2f(pp[4 * g] - (base + a0));
                        run += __uint_as_float(rr[0]) + __uint_as_float(rr[1]);
                    }
                carry = run;
            }
            u32x4 pw[4];
#pragma unroll
            for (int k = 0; k < 2; ++k) { pw[k] = (u32x4){cvtpk(p0[8 * k], p0[8 * k + 1]), cvtpk(p0[8 * k + 2], p0[8 * k + 3]), cvtpk(p0[8 * k + 4], p0[8 * k + 5]), cvtpk(p0[8 * k + 6], p0[8 * k + 7])};
                pw[2 + k] = (u32x4){cvtpk(p1[8 * k], p1[8 * k + 1]), cvtpk(p1[8 * k + 2], p1[8 * k + 3]), cvtpk(p1[8 * k + 4], p1[8 * k + 5]), cvtpk(p1[8 * k + 6], p1[8 * k + 7])}; }
            const LAS unsigned char* vp = Vs + ((lane >> 4) & 1) * 32 + (lane & 3) * 8 + (4 * hi + ((lane & 15) >> 2)) * 64;
#pragma unroll
            for (int dh = 0; dh < 2; ++dh)
#pragma unroll
                for (int kg = 0; kg < 4; ++kg) { const s16x4 lo = vtr(vp + dh * 4096 + kg * 1024), hh = vtr(vp + dh * 4096 + kg * 1024 + 512);
                    const bf16x8 vf = (bf16x8){lo[0], lo[1], lo[2], lo[3], hh[0], hh[1], hh[2], hh[3]};
                    o[dh] = __builtin_amdgcn_mfma_f32_32x32x16_bf16(vf, __builtin_bit_cast(bf16x8, pw[kg]), o[dh], 0, 0, 0); }
        }
        asm volatile("s_waitcnt vmcnt(0) lgkmcnt(0)\n\ts_barrier" ::: "memory");
    }
#undef ATT_ISSUE
    if (wid < nact) {
        float inv = 1.f;
        if (FOX) { auto rr = __builtin_amdgcn_permlane32_swap(__float_as_uint(lsum), __float_as_uint(lsum), false, false); inv = 1.f / (__uint_as_float(rr[0]) + __uint_as_float(rr[1])); }
        if (tq >= 0) { bf16_t* op = O + (rowbase + tq) * D + (FOX ? 512 : 0) + h * 64 + 4 * hi;
#pragma unroll
            for (int dh = 0; dh < 2; ++dh)
#pragma unroll
                for (int g = 0; g < 4; ++g) { u32x2 w; w.x = cvtpk(o[dh][4 * g] * inv, o[dh][4 * g + 1] * inv); w.y = cvtpk(o[dh][4 * g + 2] * inv, o[dh][4 * g + 3] * inv);
                    *(u32x2*)(op + 32 * dh + 8 * g) = w; } }
    }
}
}

#define XB_TMO      128
#define XB_XCNT(j)  (256  + 64 * (j))
#define XB_XSUB(j)  (1280 + 64 * (j))
#define XB_XGEN(j)  (2304 + 64 * (j))
#define XB_TOP      3328
#define XB_TOPGEN   3392
#define XCD_BAR_WORDS 3456
#define XB_SPIN_CAP (1u << 18)
__device__ __forceinline__ unsigned xb_ld(unsigned* p)              { return __hip_atomic_load(p, __ATOMIC_RELAXED, __HIP_MEMORY_SCOPE_AGENT); }
__device__ __forceinline__ unsigned xb_add(unsigned* p, unsigned v) { return __hip_atomic_fetch_add(p, v, __ATOMIC_RELAXED, __HIP_MEMORY_SCOPE_AGENT); }
__device__ __forceinline__ unsigned xb_xcc_id() { return (unsigned)__builtin_amdgcn_s_getreg((3 << 11) | 20) & 0xFu; }
#define XB_SPIN(cond, bar) do { unsigned _sp = 0; while (cond) { __builtin_amdgcn_s_sleep(1); \
    if ((++_sp & 255u) == 0u) { if (xb_ld(&(bar)[XB_TMO])) break; if (_sp > XB_SPIN_CAP) { atomicAdd(&(bar)[XB_TMO], 1u); break; } } } } while (0)
struct XcdBarrier { unsigned* bar; unsigned x; volatile LAS unsigned* st; };
__device__ __forceinline__ XcdBarrier xcd_barrier_post(unsigned* bar, volatile LAS unsigned* st) {
    XcdBarrier b; b.bar = bar; b.x = xb_xcc_id(); b.st = st;
    if (threadIdx.x == 0) (void)xb_add(&bar[XB_XCNT(b.x)], 1u);
    return b;
}
__device__ __forceinline__ void xcd_barrier_complete(unsigned* bar, unsigned x, unsigned& nloc, unsigned& nx) {
    const unsigned G = gridDim.x * gridDim.y * gridDim.z;
    unsigned sum, cnt, mine, sp = 0u;
    for (;;) {
        sum = 0u; cnt = 0u; mine = 0u;
#pragma unroll
        for (unsigned j = 0; j < 16; ++j) { const unsigned c = xb_ld(&bar[XB_XCNT(j)]); sum += c; cnt += (c > 0u) ? 1u : 0u; mine = (j == x) ? c : mine; }
        if (sum == G) break;
        __builtin_amdgcn_s_sleep(1);
        if ((++sp & 255u) == 0u) { if (xb_ld(&bar[XB_TMO])) break; if (sp > XB_SPIN_CAP) { atomicAdd(&bar[XB_TMO], 1u); break; } }
    }
    nloc = mine > 0u ? mine : 1u; nx = cnt > 0u ? cnt : 1u;
}
__device__ __forceinline__ void xcd_barrier(const XcdBarrier& b) {
    asm volatile("s_waitcnt vmcnt(0)" ::: "memory");
    __syncthreads();
    if (threadIdx.x == 0) {
        unsigned* bar = b.bar;
        __builtin_amdgcn_s_waitcnt(0);
        unsigned nloc = b.st[0], nx = b.st[1];
        if (nloc == 0u) { xcd_barrier_complete(bar, b.x, nloc, nx); b.st[0] = nloc; b.st[1] = nx; }
        const unsigned old = xb_add(&bar[XB_XSUB(b.x)], 1u);
        const unsigned gen = old / nloc;
        if (old + 1u == (gen + 1u) * nloc) {
            __builtin_amdgcn_fence(__ATOMIC_RELEASE, "agent");
            asm volatile("s_waitcnt vmcnt(0)" ::: "memory");
            const unsigned og = xb_add(&bar[XB_TOP], 1u);
            const unsigned tg = og / nx;
            if (og + 1u == (tg + 1u) * nx) xb_add(&bar[XB_TOPGEN], 1u);
            else XB_SPIN(xb_ld(&bar[XB_TOPGEN]) == tg, bar);
            __builtin_amdgcn_fence(__ATOMIC_ACQUIRE, "agent");
            xb_add(&bar[XB_XGEN(b.x)], 1u);
            asm volatile("s_waitcnt vmcnt(0)" ::: "memory");
        } else {
            XB_SPIN(xb_ld(&bar[XB_XGEN(b.x)]) == gen, bar);
            __builtin_amdgcn_fence(__ATOMIC_ACQUIRE, "agent");
            asm volatile("s_waitcnt vmcnt(0)" ::: "memory");
        }
    }
    __syncthreads();
}

__device__ __forceinline__ void transpose_item(const float* W, int ldw, int K, bf16_t* WT, int k0, int dst0, int src0, const float* kscale, LAS float* scr, int lane) {
#pragma unroll 8
    for (int i = 0; i < 32; ++i) { const int kk = 2 * i + (lane >> 5); float v = W[(size_t)(k0 + kk) * ldw + src0 + (lane & 31)]; if (kscale) v *= kscale[k0 + kk]; scr[kk * 33 + (lane & 31)] = v; }
    asm volatile("s_waitcnt lgkmcnt(0)" ::: "memory");
    const int c = lane & 7;
#pragma unroll
    for (int j = 0; j < 4; ++j) { const int n = (lane >> 3) + 8 * j; const LAS float* s = scr + (8 * c) * 33 + n;
        u32x4 o; o.x = cvtpk(s[0 * 33], s[1 * 33]); o.y = cvtpk(s[2 * 33], s[3 * 33]); o.z = cvtpk(s[4 * 33], s[5 * 33]); o.w = cvtpk(s[6 * 33], s[7 * 33]);
        *(u32x4*)(WT + (size_t)(dst0 + n) * K + k0 + 8 * c) = o; }
    asm volatile("s_waitcnt lgkmcnt(0)" ::: "memory");
}

struct Args { const float *x, *meta, *g1, *w_in, *bf, *wbsb, *wbfx, *wout, *g2, *wup, *convw, *wdown, *gf; float* out; unsigned char* ws; };

constexpr int LDS_BYTES = 147456;
__global__ void __launch_bounds__(512, 2) fwd_mega(Args a) {
    extern __shared__ __attribute__((aligned(16))) unsigned char lds_[];
    LAS unsigned char* lds = (LAS unsigned char*)lds_;
    cg::grid_group grid = cg::this_grid();
    const int tid = threadIdx.x, lane = tid & 63, wave = __builtin_amdgcn_readfirstlane(tid >> 6);
    const int G = gridDim.x, bx = blockIdx.x;
    const int gw = bx * 8 + wave, NGW = G * 8;
    unsigned char* ws = a.ws;
    volatile LAS unsigned* misc = (volatile LAS unsigned*)(lds + LDS_BYTES - 64);
    if (tid < 16) misc[tid] = 0u;
    __syncthreads();
    const XcdBarrier xbar = xcd_barrier_post((unsigned*)(ws + WS_BAR), misc);
    float* ss1 = (float*)(ws + WS_SS1); float* ss2 = (float*)(ws + WS_SS2); float* fl = (float*)(ws + WS_FL); float* cum = (float*)(ws + WS_CUM); float* metah = (float*)(ws + WS_METAH);
    bf16_t* Win_t = (bf16_t*)(ws + WS_WIN); bf16_t* Wbsb_t = (bf16_t*)(ws + WS_WBSB); bf16_t* Wbfx_t = (bf16_t*)(ws + WS_WBFX); bf16_t* Wout_t = (bf16_t*)(ws + WS_WOUT);
    bf16_t* Wup_t = (bf16_t*)(ws + WS_WUP); bf16_t* Wdn_t = (bf16_t*)(ws + WS_WDN);
    bf16_t* XN = (bf16_t*)(ws + WS_XN); bf16_t* QKV = (bf16_t*)(ws + WS_QKV); bf16_t* GT = (bf16_t*)(ws + WS_G); bf16_t* H1B = GT; bf16_t* ACT = QKV; bf16_t* MG = XN; bf16_t* OB = (bf16_t*)(ws + WS_O);

    {
        LAS float* scr = (LAS float*)(lds + wave * 8704);
        LAS float* wfl = (LAS float*)(lds + 69632);
        for (int idx = tid; idx < 8192; idx += 512) { const int k = idx >> 3, j = idx & 7; wfl[j * 1024 + k] = a.w_in[(size_t)k * INCOLS + NQKV + j]; }
        for (int i = bx * 512 + tid; i < M; i += G * 512) { ss1[i] = 0.f; if (i < NB * SEQ) ss2[i] = 0.f; }
        constexpr int I_IN = 16 * 160, I_BR = 8 * 32, I_OUT = 16 * 32, I_UP = 16 * 176, I_DN = 44 * 32;
        constexpr int NITEMS = I_IN + 2 * I_BR + I_OUT + I_UP + I_DN;
        for (int it = gw; it < NITEMS; it += NGW) {
            int r = it;
            if (r < I_IN) { const int kb = r / 160, nb = r % 160, d0 = 32 * nb; transpose_item(a.w_in, INCOLS, D, Win_t, 64 * kb, d0, d0 < NQKV ? d0 : d0 + 8, nullptr, scr, lane); continue; } r -= I_IN;
            if (r < I_BR) { const int kb = r / 32, nb = r % 32; transpose_item(a.wbsb, D, 512, Wbsb_t, 64 * kb, 32 * nb, 32 * nb, nullptr, scr, lane); continue; } r -= I_BR;
            if (r < I_BR) { const int kb = r / 32, nb = r % 32; transpose_item(a.wbfx, D, 512, Wbfx_t, 64 * kb, 32 * nb, 32 * nb, nullptr, scr, lane); continue; } r -= I_BR;
            if (r < I_OUT) { const int kb = r / 32, nb = r % 32; transpose_item(a.wout, D, D, Wout_t, 64 * kb, 32 * nb, 32 * nb, nullptr, scr, lane); continue; } r -= I_OUT;
            if (r < I_UP) { const int kb = r / 176, nb = r % 176, d0 = 32 * nb, pn = d0 >> 8, bj = (d0 >> 7) & 1, j = d0 & 127;
                transpose_item(a.wup, NUP, D, Wup_t, 64 * kb, d0, bj * DFF + 128 * pn + j, a.g2, scr, lane); continue; } r -= I_UP;
            { const int kb = r / 32, nb = r % 32; transpose_item(a.wdown, D, DFF, Wdn_t, 64 * kb, 32 * nb, 32 * nb, nullptr, scr, lane); }
        }
        __syncthreads();
        f32x4 gv[4];
#pragma unroll
        for (int j = 0; j < 4; ++j) gv[j] = ((const f32x4*)a.g1)[lane + 64 * j];
        for (int m = gw; m < M; m += NGW) {
            const int b = m / L, t = m - b * L;
            const f32x4* xr = (const f32x4*)((t < NMETA) ? a.meta + (size_t)t * D : a.x + ((size_t)b * SEQ + (t - NMETA)) * D) + lane;
            f32x4 v[4]; float s = 0.f;
#pragma unroll
            for (int j = 0; j < 4; ++j) { v[j] = xr[64 * j]; s += (v[j].x * v[j].x + v[j].y * v[j].y) + (v[j].z * v[j].z + v[j].w * v[j].w); }
            const float r = __builtin_amdgcn_rsqf(wave_sum(s) * (1.f / D) + EPS);
#pragma unroll
            for (int j = 0; j < 4; ++j) v[j] = v[j] * r * gv[j];
            u32x2* o8 = (u32x2*)(XN + (size_t)m * D) + lane;
#pragma unroll
            for (int j = 0; j < 4; ++j) { u32x2 w; w.x = cvtpk(v[j].x, v[j].y); w.y = cvtpk(v[j].z, v[j].w); o8[64 * j] = w; }
            float mine = 0.f;
#pragma unroll
            for (int jj = 0; jj < 8; ++jj) { float d = 0.f;
#pragma unroll
                for (int j = 0; j < 4; ++j) { const f32x4 w = *(const LAS f32x4*)(wfl + jj * 1024 + 4 * (lane + 64 * j)); d += (v[j].x * w.x + v[j].y * w.y) + (v[j].z * w.z + v[j].w * w.w); }
                d = wave_sum(d); if (lane == jj) mine = d; }
            if (lane < 8) fl[(size_t)m * 8 + lane] = mine;
        }
    }
    grid.sync();

    {
        pg8::Gemm g{XN, Win_t, D, D, 256, 0}; pg8::StaticOrder S; S.init(M / 256, NIN / 256, G, bx);
        pg8::EpiIn E{QKV, GT};
        pg8::gemm_phase<pg8::EpiIn>(lds, g, S, E);
        if (wave == 0) for (int seq = bx; seq < NB * 8; seq += G) { const int b = seq >> 3, h = seq & 7; const float bias = a.bf[h]; float carry = 0.f;
            for (int c = 0; c < (L + 63) / 64; ++c) { const int t = 64 * c + lane; float v = 0.f;
                if (t < L) { const float xx = fl[((size_t)b * L + t) * 8 + h] + bias; v = __builtin_fminf(xx, 0.f) * LOG2E - __builtin_amdgcn_logf(1.f + __builtin_amdgcn_exp2f(-__builtin_fabsf(xx) * LOG2E)); }
#pragma unroll
                for (int o = 1; o < 64; o <<= 1) { const float n = __shfl_up(v, o); if (lane >= o) v += n; }
                if (t < L) cum[(size_t)seq * L + t] = carry + v;
                carry += __shfl(v, 63); } }
    }
    xcd_barrier(xbar);

#ifndef ATT_REPEAT
#define ATT_REPEAT 1
#endif
    for (int rep = 0; rep < ATT_REPEAT; ++rep)
    for (int bh = bx; bh < NB * 8; bh += G) {
        const int b = bh >> 3, h = bh & 7;
        for (int jj = 0; jj < 9; ++jj) { const int j = 7 - jj; const bool mt = j < 0; att::unit<false>(QKV, OB, nullptr, b, h, mt ? -16 : NMETA + 256 * j, mt ? 1 : 8, mt ? 1 : 4 * j + 5, lds); }
        for (int jj = 0; jj < 9; ++jj) { const int j = 7 - jj; const bool mt = j < 0; att::unit<true>(QKV, OB, cum + (size_t)bh * L, b, h, mt ? -16 : NMETA + 256 * j, mt ? 1 : 8, mt ? 1 : 4 * j + 5, lds); }
    }
    xcd_barrier(xbar);

    {
        pg8::StaticOrder S; S.init(M / 256, D / 256, G, bx);
        { pg8::Gemm g{OB, Wbsb_t, D, 512, 256, 0}; pg8::EpiBr<0> E{GT, MG}; pg8::gemm_phase<pg8::EpiBr<0>>(lds, g, S, E); }
        { pg8::Gemm g{OB + 512, Wbfx_t, D, 512, 256, 0}; pg8::EpiBr<1> E{GT, MG}; pg8::gemm_phase<pg8::EpiBr<1>>(lds, g, S, E); }
    }
    xcd_barrier(xbar);

    {
        pg8::Gemm g{MG, Wout_t, D, D, 256, 0}; pg8::StaticOrder S; S.init(M / 256, D / 256, G, bx);
        pg8::EpiOut E{a.x, a.meta, a.out, metah, H1B, ss1};
        pg8::gemm_phase<pg8::EpiOut>(lds, g, S, E);
    }
    xcd_barrier(xbar);

    {
        pg8::Gemm g{H1B, Wup_t, D, D, 254, -2}; pg8::StaticOrder S; S.init(261, NUP / 256, G, bx);
        pg8::EpiUp E{ss1, a.convw, ACT, (LAS float*)(lds + pg8::STAGE_BYTES)};
        pg8::gemm_phase<pg8::EpiUp>(lds, g, S, E);
    }
    xcd_barrier(xbar);

    {
        pg8::Gemm g{ACT, Wdn_t, DFF, DFF, 256, 0}; pg8::StaticOrder S; S.init(NB * SEQ / 256, D / 256, G, bx);
        pg8::EpiDown E{a.out, ss2};
        pg8::gemm_phase<pg8::EpiDown>(lds, g, S, E);
    }
    xcd_barrier(xbar);

    {
        f32x4 gv[4];
#pragma unroll
        for (int j = 0; j < 4; ++j) gv[j] = ((const f32x4*)a.gf)[lane + 64 * j];
        for (int m = gw; m < NB * SEQ; m += NGW) {
            const float r = __builtin_amdgcn_rsqf(ss2[m] * (1.f / D) + EPS);
            f32x4* p = (f32x4*)(a.out + (size_t)m * D) + lane;
#pragma unroll
            for (int j = 0; j < 4; ++j) p[64 * j] = p[64 * j] * r * gv[j];
        }
    }
}

extern "C" void kernel_launch(void* const* d_in, const int* in_sizes, int n_in, void* d_out, int out_size, void* d_ws, size_t ws_size, hipStream_t stream) {
    static int grid = 0;
    if (grid == 0) {
        if (n_in != 13 || out_size != NB * SEQ * D || ws_size < WS_END) { fprintf(stderr, "kernel_launch: unexpected shapes (n_in %d out %d ws %zu)\n", n_in, out_size, ws_size); grid = -1; return; }
        int dev = 0, cus = 0, per_cu = 0;
        (void)hipGetDevice(&dev);
        (void)hipDeviceGetAttribute(&cus, hipDeviceAttributeMultiprocessorCount, dev);
        (void)hipFuncSetAttribute((const void*)fwd_mega, hipFuncAttributeMaxDynamicSharedMemorySize, LDS_BYTES);
        (void)hipOccupancyMaxActiveBlocksPerMultiprocessor(&per_cu, (const void*)fwd_mega, 512, LDS_BYTES);
        if (per_cu < 1) per_cu = 1;
        grid = cus * per_cu;
    }
    if (grid < 0) return;
    Args a{};
    a.x = (const float*)d_in[0]; a.meta = (const float*)d_in[1]; a.g1 = (const float*)d_in[2]; a.w_in = (const float*)d_in[3]; a.bf = (const float*)d_in[4];
    a.wbsb = (const float*)d_in[5]; a.wbfx = (const float*)d_in[6]; a.wout = (const float*)d_in[7]; a.g2 = (const float*)d_in[8]; a.wup = (const float*)d_in[9];
    a.convw = (const float*)d_in[10]; a.wdown = (const float*)d_in[11]; a.gf = (const float*)d_in[12]; a.out = (float*)d_out; a.ws = (unsigned char*)d_ws;
    (void)hipMemsetAsync((char*)d_ws + WS_BAR, 0, WS_BAR_BYTES, stream);
    void* args[] = {&a};
    hipError_t e = hipLaunchCooperativeKernel((const void*)fwd_mega, dim3(grid), dim3(512), args, LDS_BYTES, stream);
    if (e != hipSuccess) fprintf(stderr, "cooperative launch failed: %s (grid %d)\n", hipGetErrorString(e), grid);
}
```

```cpp
#include <hip/hip_runtime.h>
#include <hip/hip_cooperative_groups.h>
#include <cstdio>
#include <cstdint>
namespace cg = cooperative_groups;

#define LAS __attribute__((address_space(3)))
typedef unsigned short bf16_t;
typedef short bf16x8 __attribute__((ext_vector_type(8)));
typedef short s16x4 __attribute__((ext_vector_type(4)));
typedef float f32x2 __attribute__((ext_vector_type(2)));
typedef float f32x4 __attribute__((ext_vector_type(4)));
typedef float f32x16 __attribute__((ext_vector_type(16)));
typedef unsigned u32x2 __attribute__((ext_vector_type(2)));
typedef unsigned u32x4 __attribute__((ext_vector_type(4)));
typedef __bf16 bf16x2_t __attribute__((ext_vector_type(2)));

constexpr int NB = 32, SEQ = 2048, NMETA = 16, L = SEQ + NMETA, D = 1024, M = NB * L, DFF = 2816;
constexpr int NQKV = 3072, NGATE = 2048, NIN = 5120, INCOLS = 5128, NUP = 2 * DFF;
constexpr float EPS = 1e-6f, LOG2E = 1.4426950408889634f, C2 = 0.125f * LOG2E;
static_assert(M % 256 == 0, "M tiles");

constexpr size_t MiB = 1u << 20;
constexpr size_t WS_BAR = 800 * 1024, WS_BAR_BYTES = 16384;
constexpr size_t WS_SS1 = 0, WS_SS2 = 512 * 1024, WS_FL = 1 * MiB, WS_CUM = 4 * MiB, WS_METAH = 7 * MiB;
constexpr size_t WS_WIN = 10 * MiB, WS_WBSB = 20 * MiB, WS_WBFX = 21 * MiB, WS_WOUT = 22 * MiB, WS_WUP = 24 * MiB, WS_WDN = 35 * MiB;
constexpr size_t WS_XN = 42 * MiB;
constexpr size_t WS_QKV = 172 * MiB;
constexpr size_t WS_G = 560 * MiB;
constexpr size_t WS_O = 820 * MiB;
constexpr size_t WS_END = 950 * MiB;

__device__ __forceinline__ unsigned cvtpk(float lo, float hi) { f32x2 v = {lo, hi}; bf16x2_t b = __builtin_convertvector(v, bf16x2_t); return __builtin_bit_cast(unsigned, b); }
__device__ __forceinline__ float bflo(unsigned u) { return __uint_as_float(u << 16); }
__device__ __forceinline__ float bfhi(unsigned u) { return __uint_as_float(u & 0xffff0000u); }
__device__ __forceinline__ float sigmoid_(float x) { return __builtin_amdgcn_rcpf(1.f + __builtin_amdgcn_exp2f(-LOG2E * x)); }
__device__ __forceinline__ float wave_sum(float v) {
#pragma unroll
    for (int o = 1; o < 64; o <<= 1) v += __shfl_xor(v, o);
    return v;
}

namespace pg8 {
constexpr int BM = 256, BK = 64, HALF = 128, HTB = HALF * BK * 2, STAGE_BYTES = 8 * HTB, NXCD = 8, WGM = 8;
__host__ __device__ __forceinline__ int lds_byte(int r, int c) { const int st = (r >> 4) * 2 + (c >> 5), rr = r & 15, cc = c & 31, ob = rr * 64 + cc * 2; return st * 1024 + (ob ^ (((ob >> 9) & 1) << 5)); }
__host__ __device__ __forceinline__ void stage_rc(int b, int& R, int& C) { const int st = b / 1024, sb = b % 1024, swz = sb ^ (((sb >> 9) & 1) << 5); R = (st >> 1) * 16 + swz / 64; C = (st & 1) * 32 + (swz % 64) / 2; }
__host__ __device__ __forceinline__ int perm32(int rho) { const int n = rho >> 4, i = rho & 15; return 8 * (i >> 2) + 4 * n + (i & 3); }

struct Unit { int pm, pn; };
struct Gemm { const bf16_t* A; const bf16_t* Bt; int lda, K, mstep, moff; };

struct StaticOrder {
    int nM, nN, nwg, G, c;
    __device__ void init(int nM_, int nN_, int G_, int c_) { nM = nM_; nN = nN_; nwg = nM * nN; G = G_; c = c_; }
    __device__ bool next(int i, Unit& u) const {
        const long Lx = (long)i * G + c; if (Lx >= nwg) return false;
        int wgid = (int)Lx; { const int q = nwg / NXCD, r = nwg % NXCD, xcd = wgid % NXCD, off = wgid / NXCD; wgid = (xcd < r ? xcd * (q + 1) : r * (q + 1) + (xcd - r) * q) + off; }
        const int nig = WGM * nN, gid = wgid / nig, fm = gid * WGM, gsz = (nM - fm) < WGM ? (nM - fm) : WGM;
        u.pm = fm + ((wgid % nig) % gsz); u.pn = (wgid % nig) / gsz; return true;
    }
};

template <class Epi>
__device__ __forceinline__ void gemm_phase(LAS unsigned char* lds, const Gemm g, const StaticOrder& S, const Epi& E) {
    const int tid = threadIdx.x, wid = __builtin_amdgcn_readfirstlane(tid >> 6), lane = tid & 63, wr = wid >> 2, wc = wid & 3, fr = lane & 15, fq = lane >> 4;
    const int K = g.K, nt = K / BK, lda = g.lda;
    unsigned voffA[2], voffB[2];
#pragma unroll
    for (int i = 0; i < 2; ++i) { int R, C; stage_rc(tid * 16 + i * 8192, R, C); const int Rb = (R & ~31) + perm32(R & 31);
        voffA[i] = (unsigned)(R * lda + C) * 2u; voffB[i] = (unsigned)(Rb * K + C) * 2u; }
    const size_t kstep = (size_t)(BK * 2);
    const size_t hstA = (size_t)HALF * lda * 2, hstB = (size_t)HALF * K * 2;
    const unsigned ldsw = (unsigned)wid * 1024u;
    const int aoff = lds_byte(wr * 64 + fr, fq * 8), boff = lds_byte(wc * 32 + fr, fq * 8);
#define PG8_SA(b, h) (((b) * 2 + (h)) * HTB)
#define PG8_SB(b, h) ((4 + (b) * 2 + (h)) * HTB)
#define PG8_STAGE(bufoff, gbase, voff) do { _Pragma("unroll") for (int _i = 0; _i < 2; ++_i) \
        __builtin_amdgcn_global_load_lds((const unsigned*)((const char*)(gbase) + (voff)[_i]), (LAS unsigned*)(lds + (bufoff) + ldsw + _i * 8192), 16, 0, 0); } while (0)
#define PG8_LDA(dst, b, h) do { _Pragma("unroll") for (int m = 0; m < 4; ++m) _Pragma("unroll") for (int k = 0; k < 2; ++k) dst[m][k] = *(const LAS bf16x8*)(lds + PG8_SA(b, h) + aoff + m * 2048 + k * 1024); } while (0)
#define PG8_LDB(dst, b, h) do { _Pragma("unroll") for (int n = 0; n < 2; ++n) _Pragma("unroll") for (int k = 0; k < 2; ++k) dst[n][k] = *(const LAS bf16x8*)(lds + PG8_SB(b, h) + boff + n * 2048 + k * 1024); } while (0)
#define PG8_MMA(ai, bj, At, Bt) do { __builtin_amdgcn_s_setprio(1); _Pragma("unroll") for (int m = 0; m < 4; ++m) _Pragma("unroll") for (int n = 0; n < 2; ++n) _Pragma("unroll") for (int k = 0; k < 2; ++k) \
        acc[ai][bj][m][n] = __builtin_amdgcn_mfma_f32_16x16x32_bf16(Bt[n][k], At[m][k], acc[ai][bj][m][n], 0, 0, 0); __builtin_amdgcn_s_setprio(0); } while (0)
#define PG8_WAIT_V(n) asm volatile("s_waitcnt vmcnt(" #n ")" ::: "memory")
#define PG8_WAIT_L(n) asm volatile("s_waitcnt lgkmcnt(" #n ")" ::: "memory")
#define PG8_BAR __builtin_amdgcn_s_barrier()
#define PG8_SCHED __builtin_amdgcn_sched_barrier(0)
    Unit cur, nxt; int ui = 0;
    if (!S.next(0, cur)) return;
    f32x4 acc[2][2][4][2];
#pragma unroll
    for (int a = 0; a < 2; ++a)
#pragma unroll
        for (int b = 0; b < 2; ++b)
#pragma unroll
            for (int m = 0; m < 4; ++m)
#pragma unroll
                for (int n = 0; n < 2; ++n) acc[a][b][m][n] = (f32x4){0.f, 0.f, 0.f, 0.f};
    bf16x8 At[4][2], B0[2][2], B1[2][2];
    const char* cA = (const char*)g.A + ((long)cur.pm * g.mstep + g.moff) * (long)lda * 2; const char* cB = (const char*)g.Bt + (size_t)cur.pn * 2 * hstB;
    PG8_STAGE(PG8_SB(0, 0), cB, voffB); PG8_STAGE(PG8_SB(0, 1), cB + hstB, voffB); PG8_STAGE(PG8_SA(0, 0), cA, voffA); PG8_STAGE(PG8_SA(0, 1), cA + hstA, voffA);
    if (wr == 1) PG8_BAR;
    PG8_WAIT_V(2); PG8_BAR;
    PG8_STAGE(PG8_SB(1, 0), cB + kstep, voffB); PG8_STAGE(PG8_SA(1, 0), cA + kstep, voffA); PG8_STAGE(PG8_SB(1, 1), cB + hstB + kstep, voffB);
    PG8_WAIT_V(6); PG8_BAR;
    for (;;) {
        const bool has_next = S.next(ui + 1, nxt);
        const char* nA = has_next ? (const char*)g.A + ((long)nxt.pm * g.mstep + g.moff) * (long)lda * 2 : cA; const char* nB = has_next ? (const char*)g.Bt + (size_t)nxt.pn * 2 * hstB : cB;
        for (int t = 0; t < nt; t += 2) {
            const bool last = (t == nt - 2);
            const char* a1 = cA + (size_t)(t + 1) * kstep;
            const char* a2 = last ? nA : cA + (size_t)(t + 2) * kstep; const char* b2 = last ? nB : cB + (size_t)(t + 2) * kstep;
            const char* a3 = a2 + kstep; const char* b3 = b2 + kstep;
            PG8_LDB(B0, 0, 0); PG8_LDB(B1, 0, 1); PG8_SCHED; PG8_LDA(At, 0, 0); PG8_STAGE(PG8_SA(1, 1), a1 + hstA, voffA);
            PG8_WAIT_V(8); PG8_WAIT_L(0); PG8_BAR; PG8_MMA(0, 0, At, B0); PG8_MMA(0, 1, At, B1); PG8_BAR; PG8_SCHED;
            PG8_LDA(At, 0, 1); PG8_STAGE(PG8_SB(0, 0), b2, voffB); PG8_STAGE(PG8_SB(0, 1), b2 + hstB, voffB); PG8_STAGE(PG8_SA(0, 0), a2, voffA);
            PG8_WAIT_V(8); PG8_WAIT_L(0); PG8_BAR; PG8_MMA(1, 0, At, B0); PG8_MMA(1, 1, At, B1); PG8_BAR; PG8_SCHED;
            PG8_LDB(B0, 1, 0); PG8_LDB(B1, 1, 1); PG8_SCHED; PG8_LDA(At, 1, 0); PG8_STAGE(PG8_SA(0, 1), a2 + hstA, voffA);
            PG8_WAIT_V(8); PG8_WAIT_L(0); PG8_BAR; PG8_MMA(0, 0, At, B0); PG8_MMA(0, 1, At, B1); PG8_BAR; PG8_SCHED;
            PG8_LDA(At, 1, 1); PG8_STAGE(PG8_SB(1, 0), b3, voffB); PG8_STAGE(PG8_SB(1, 1), b3 + hstB, voffB); PG8_STAGE(PG8_SA(1, 0), a3, voffA);
            PG8_WAIT_V(8); PG8_WAIT_L(0); PG8_BAR; PG8_MMA(1, 0, At, B0); PG8_MMA(1, 1, At, B1); PG8_BAR; PG8_SCHED;
        }
        if (wr == 0) PG8_BAR;
        E(acc, cur, wr, wc, fr, fq);
        if (!has_next) break;
#pragma unroll
        for (int a = 0; a < 2; ++a)
#pragma unroll
            for (int b = 0; b < 2; ++b)
#pragma unroll
                for (int m = 0; m < 4; ++m)
#pragma unroll
                    for (int n = 0; n < 2; ++n) acc[a][b][m][n] = (f32x4){0.f, 0.f, 0.f, 0.f};
        cur = nxt; cA = nA; cB = nB; ++ui;
        if (wr == 1) PG8_BAR;
    }
    PG8_WAIT_V(0);
    PG8_BAR;
#undef PG8_SA
#undef PG8_SB
#undef PG8_STAGE
#undef PG8_LDA
#undef PG8_LDB
#undef PG8_MMA
}

typedef f32x4 Acc[2][2][4][2];
struct EpiIn {
    bf16_t* Qb; bf16_t* KVH; bf16_t* G;
    __device__ __forceinline__ void operator()(const Acc& acc, const Unit& u, int wr, int wc, int fr, int fq) const {
        const int row0 = u.pm * BM + wr * 64 + fr; const int pn = u.pn;
        const bool gate = pn >= 12, isq = (pn < 2) || (pn == 6) || (pn == 7);
        const int kind = (pn < 6) ? ((pn - 2) >> 1) : 2 + ((pn - 8) >> 1);
#pragma unroll
        for (int ai = 0; ai < 2; ++ai)
#pragma unroll
            for (int m = 0; m < 4; ++m) { const int row = row0 + ai * HALF + m * 16;
                bf16_t* rowp; int bjstride;
                if (gate) { rowp = G + (size_t)row * NGATE + (pn - 12) * 256 + wc * 32 + 8 * fq; bjstride = HALF; }
                else if (isq) { rowp = Qb + (size_t)row * D + (pn < 2 ? pn * 256 : 512 + (pn - 6) * 256) + wc * 32 + 8 * fq; bjstride = HALF; }
                else { const int b = row / L, t = row - b * L; const int head = 4 * (pn & 1) + (wc >> 1);
                    rowp = KVH + ((size_t)((kind * NB + b) * 8 + head) * L + t) * 64 + (wc & 1) * 32 + 8 * fq; bjstride = 2 * L * 64; }
#pragma unroll
                for (int bj = 0; bj < 2; ++bj) { f32x4 v0 = acc[ai][bj][m][0], v1 = acc[ai][bj][m][1];
                    if (gate) {
#pragma unroll
                        for (int j = 0; j < 4; ++j) { v0[j] = sigmoid_(v0[j]); v1[j] = sigmoid_(v1[j]); } }
                    else if (isq) { v0 = v0 * C2; v1 = v1 * C2; }
                    u32x4 w; w.x = cvtpk(v0[0], v0[1]); w.y = cvtpk(v0[2], v0[3]); w.z = cvtpk(v1[0], v1[1]); w.w = cvtpk(v1[2], v1[3]);
                    *(u32x4*)(rowp + (size_t)bj * bjstride) = w; } }
    }
};
template <int PASS> struct EpiBr {
    const bf16_t* G; bf16_t* MG;
    __device__ __forceinline__ void operator()(const Acc& acc, const Unit& u, int wr, int wc, int fr, int fq) const {
        const int row0 = u.pm * BM + wr * 64 + fr, col0 = u.pn * BM + wc * 32 + 8 * fq;
#pragma unroll
        for (int ai = 0; ai < 2; ++ai)
#pragma unroll
            for (int m = 0; m < 4; ++m) { const size_t row = (size_t)(row0 + ai * HALF + m * 16);
                const bf16_t* gp = G + row * NGATE + PASS * 1024 + col0; bf16_t* mp = MG + row * D + col0;
#pragma unroll
                for (int bj = 0; bj < 2; ++bj) { const u32x4 gv = *(const u32x4*)(gp + bj * HALF); f32x4 v0 = acc[ai][bj][m][0], v1 = acc[ai][bj][m][1];
                    v0[0] *= bflo(gv.x); v0[1] *= bfhi(gv.x); v0[2] *= bflo(gv.y); v0[3] *= bfhi(gv.y); v1[0] *= bflo(gv.z); v1[1] *= bfhi(gv.z); v1[2] *= bflo(gv.w); v1[3] *= bfhi(gv.w);
                    if (PASS == 1) { const u32x4 tv = *(const u32x4*)(mp + bj * HALF);
                        v0[0] += bflo(tv.x); v0[1] += bfhi(tv.x); v0[2] += bflo(tv.y); v0[3] += bfhi(tv.y); v1[0] += bflo(tv.z); v1[1] += bfhi(tv.z); v1[2] += bflo(tv.w); v1[3] += bfhi(tv.w); }
                    u32x4 w; w.x = cvtpk(v0[0], v0[1]); w.y = cvtpk(v0[2], v0[3]); w.z = cvtpk(v1[0], v1[1]); w.w = cvtpk(v1[2], v1[3]);
                    *(u32x4*)(mp + bj * HALF) = w; } }
    }
};
struct EpiOut {
    const float* x; const float* meta; float* out; float* metah; bf16_t* H1B; float* ss1;
    __device__ __forceinline__ void operator()(const Acc& acc, const Unit& u, int wr, int wc, int fr, int fq) const {
        const int row0 = u.pm * BM + wr * 64 + fr, col0 = u.pn * BM + wc * 32 + 8 * fq;
#pragma unroll
        for (int ai = 0; ai < 2; ++ai)
#pragma unroll
            for (int m = 0; m < 4; ++m) { const int row = row0 + ai * HALF + m * 16; const int b = row / L, t = row - b * L;
                const float* hs = (t < NMETA) ? meta + (size_t)t * D : x + ((size_t)b * SEQ + (t - NMETA)) * D;
                float* hd = (t < NMETA) ? metah + ((size_t)b * NMETA + t) * D : out + ((size_t)b * SEQ + (t - NMETA)) * D;
                float ss = 0.f;
#pragma unroll
                for (int bj = 0; bj < 2; ++bj) { const int c = col0 + bj * HALF;
                    const f32x4 h0 = *(const f32x4*)(hs + c), h1 = *(const f32x4*)(hs + c + 4);
                    const f32x4 v0 = acc[ai][bj][m][0] + h0, v1 = acc[ai][bj][m][1] + h1;
                    *(f32x4*)(hd + c) = v0; *(f32x4*)(hd + c + 4) = v1;
                    ss += (v0[0] * v0[0] + v0[1] * v0[1]) + (v0[2] * v0[2] + v0[3] * v0[3]) + (v1[0] * v1[0] + v1[1] * v1[1]) + (v1[2] * v1[2] + v1[3] * v1[3]);
                    u32x4 w; w.x = cvtpk(v0[0], v0[1]); w.y = cvtpk(v0[2], v0[3]); w.z = cvtpk(v1[0], v1[1]); w.w = cvtpk(v1[2], v1[3]);
                    *(u32x4*)(H1B + (size_t)row * D + c) = w; }
                ss += __shfl_xor(ss, 16); ss += __shfl_xor(ss, 32);
                if (fq == 0) unsafeAtomicAdd(ss1 + row, ss); }
    }
};
__device__ __forceinline__ float fmac_ror1(float acc, float x, float c) { asm("s_nop 1\n\tv_fmac_f32_dpp %0, %1, %2 row_ror:1 row_mask:0xf bank_mask:0xf" : "+v"(acc) : "v"(x), "v"(c)); return acc; }
__device__ __forceinline__ float fmac_ror2(float acc, float x, float c) { asm("s_nop 1\n\tv_fmac_f32_dpp %0, %1, %2 row_ror:2 row_mask:0xf bank_mask:0xf" : "+v"(acc) : "v"(x), "v"(c)); return acc; }
struct EpiUp {
    const float* ss1; const float* convw; bf16_t* ACT; LAS float* halo;
    __device__ __forceinline__ void operator()(Acc& acc, const Unit& u, int wr, int wc, int fr, int fq) const {
        const int R0 = 254 * u.pm - 2;
        unsigned ok1 = 0, ok2 = 0, okst = 0;
#pragma unroll
        for (int ai = 0; ai < 2; ++ai)
#pragma unroll
            for (int m = 0; m < 4; ++m) { const int lr = ai * HALF + wr * 64 + m * 16 + fr, grow = R0 + lr; const bool inr = grow >= 0 && grow < M;
                const float r2 = inr ? __builtin_amdgcn_rsqf(ss1[inr ? grow : 0] * (1.f / D) + EPS) : 0.f;
                const int t = inr ? grow % L : 0;
                if (t >= 1) ok1 |= 1u << (ai * 4 + m); if (t >= 2) ok2 |= 1u << (ai * 4 + m); if (inr && lr >= 2 && t >= NMETA) okst |= 1u << (ai * 4 + m);
#pragma unroll
                for (int bj = 0; bj < 2; ++bj)
#pragma unroll
                    for (int n = 0; n < 2; ++n) acc[ai][bj][m][n] = acc[ai][bj][m][n] * r2; }
        if (fr >= 14) {
#pragma unroll
            for (int ai = 0; ai < 2; ++ai)
#pragma unroll
                for (int bj = 0; bj < 2; ++bj)
#pragma unroll
                    for (int n = 0; n < 2; ++n) *(LAS f32x4*)(halo + ((ai * 2 + wr) * 2 + (fr - 14)) * 256 + bj * HALF + wc * 32 + 8 * fq + 4 * n) = acc[ai][bj][3][n];
        }
        asm volatile("s_waitcnt lgkmcnt(0)" ::: "memory"); __builtin_amdgcn_s_barrier(); asm volatile("" ::: "memory");
        const int chn = u.pn * 128 + wc * 32 + 8 * fq;
#pragma unroll
        for (int bj = 0; bj < 2; ++bj)
#pragma unroll
            for (int n = 0; n < 2; ++n) {
                asm volatile("" ::: "memory");
                const f32x4 c0 = *(const f32x4*)(convw + (size_t)0 * NUP + bj * DFF + chn + 4 * n), c1 = *(const f32x4*)(convw + (size_t)1 * NUP + bj * DFF + chn + 4 * n), c2 = *(const f32x4*)(convw + (size_t)2 * NUP + bj * DFF + chn + 4 * n);
#pragma unroll
                for (int ai = 0; ai < 2; ++ai) {
                    const int idx = ai * 2 + wr;
                    const f32x4 hreg = (idx > 0) ? *(const LAS f32x4*)(halo + ((idx - 1) * 2 + (fr == 15 ? 1 : 0)) * 256 + bj * HALF + wc * 32 + 8 * fq + 4 * n) : (f32x4){0.f, 0.f, 0.f, 0.f};
#pragma unroll
                    for (int m = 3; m >= 0; --m) {
                        const bool t1 = (ok1 >> (ai * 4 + m)) & 1u, t2 = (ok2 >> (ai * 4 + m)) & 1u;
                        const f32x4 cu = acc[ai][bj][m][n]; const f32x4 pv = (m > 0) ? acc[ai][bj][m > 0 ? m - 1 : 0][n] : hreg; f32x4 uc;
#pragma unroll
                        for (int j = 0; j < 4; ++j) { const float x1 = (fr == 15) ? pv[j] : cu[j], x2 = (fr >= 14) ? pv[j] : cu[j];
                            const float c1m = t1 ? c1[j] : 0.f, c0m = t2 ? c0[j] : 0.f;
                            uc[j] = fmac_ror2(fmac_ror1(c2[j] * cu[j], x1, c1m), x2, c0m); }
                        acc[ai][bj][m][n] = uc;
                    }
                }
                asm volatile("" ::: "memory"); __builtin_amdgcn_sched_barrier(0);
            }
#pragma unroll
        for (int ai = 0; ai < 2; ++ai)
#pragma unroll
            for (int m = 0; m < 4; ++m) {
                const f32x4 a0 = acc[ai][0][m][0], a1 = acc[ai][0][m][1], b0 = acc[ai][1][m][0], b1 = acc[ai][1][m][1];
                float v[8];
#pragma unroll
                for (int j = 0; j < 4; ++j) { v[j] = a0[j] * sigmoid_(a0[j]) * b0[j]; v[4 + j] = a1[j] * sigmoid_(a1[j]) * b1[j]; }
                if ((okst >> (ai * 4 + m)) & 1u) { u32x4 w; w.x = cvtpk(v[0], v[1]); w.y = cvtpk(v[2], v[3]); w.z = cvtpk(v[4], v[5]); w.w = cvtpk(v[6], v[7]);
                    const int grow = R0 + ai * HALF + wr * 64 + m * 16 + fr, bb = grow / L, arow = grow - bb * L - NMETA + bb * SEQ; *(u32x4*)(ACT + (size_t)arow * DFF + chn) = w; }
                __builtin_amdgcn_sched_barrier(0);
            }
    }
};
struct EpiDown {
    float* out; float* ss2;
    __device__ __forceinline__ void operator()(const Acc& acc, const Unit& u, int wr, int wc, int fr, int fq) const {
        const int row0 = u.pm * BM + wr * 64 + fr, col0 = u.pn * BM + wc * 32 + 8 * fq;
#pragma unroll
        for (int ai = 0; ai < 2; ++ai)
#pragma unroll
            for (int m = 0; m < 4; ++m) { const int row = row0 + ai * HALF + m * 16; float* hd = out + (size_t)row * D; float ss = 0.f;
#pragma unroll
                for (int bj = 0; bj < 2; ++bj) { const int c = col0 + bj * HALF;
                    const f32x4 h0 = *(const f32x4*)(hd + c), h1 = *(const f32x4*)(hd + c + 4);
                    const f32x4 v0 = acc[ai][bj][m][0] + h0, v1 = acc[ai][bj][m][1] + h1;
                    *(f32x4*)(hd + c) = v0; *(f32x4*)(hd + c + 4) = v1;
                    ss += (v0[0] * v0[0] + v0[1] * v0[1]) + (v0[2] * v0[2] + v0[3] * v0[3]) + (v1[0] * v1[0] + v1[1] * v1[1]) + (v1[2] * v1[2] + v1[3] * v1[3]); }
                ss += __shfl_xor(ss, 16); ss += __shfl_xor(ss, 32);
                if (fq == 0) unsafeAtomicAdd(ss2 + row, ss); }
    }
};
}

namespace att {
constexpr int SLOT = 16384, LDS_KB = 4 * SLOT;
__device__ __forceinline__ void glds16(const void* gsrc, unsigned lds_dst) { unsigned keep;
    asm volatile("s_mov_b32 %0, m0\n\ts_mov_b32 m0, %2\n\ts_nop 0\n\tglobal_load_lds_dwordx4 %1, off\n\ts_mov_b32 m0, %0" : "=&s"(keep) : "v"(gsrc), "s"(lds_dst) : "memory"); }
__device__ __forceinline__ int crow(int r, int hi) { return (r & 3) + 8 * (r >> 2) + 4 * hi; }
__device__ __forceinline__ s16x4 vtr(const LAS unsigned char* p) { return __builtin_bit_cast(s16x4, __builtin_amdgcn_ds_read_tr16_b64_v4i16((LAS s16x4*)p)); }

template <bool FOX>
__device__ __forceinline__ void unit(const bf16_t* Qb, const bf16_t* KVH, bf16_t* O, const float* cum, int b, int h, int qt0, int nact, int NT, LAS unsigned char* lds) {
    const int tid = threadIdx.x, lane = tid & 63, r32 = lane & 31, hi = lane >> 5; const int wid = __builtin_amdgcn_readfirstlane(tid >> 6);
    const long rowbase = (long)b * L; const int colq = (FOX ? 512 : 0) + h * 64;
    const bf16_t* Kh = KVH + (size_t)(((FOX ? 2 : 0) * NB + b) * 8 + h) * L * 64; const bf16_t* Vh = KVH + (size_t)(((FOX ? 3 : 1) * NB + b) * 8 + h) * L * 64;
    const int tw0 = qt0 + 32 * wid, tq = tw0 + r32;
    const bool active = wid < nact;
    LAS float* kbs = (LAS float*)(lds + LDS_KB);
    if (FOX) { for (int p = tid; p < 64 * NT; p += 512) { const int t = p - 48; kbs[p] = (t >= 0 && t < L) ? -cum[t] : 0.f; } }
    const int kkK = 8 * wid + (lane >> 3), kkV = 16 * (wid & 3) + (lane >> 2);
    const bf16_t* kcol = Kh + (((lane & 7) ^ ((kkK >> 1) & 7)) * 8); const bf16_t* vcol = Vh + (wid >> 2) * 32 + (lane & 3) * 8;
    const unsigned lds0 = (unsigned)(uintptr_t)lds;
#define ATT_TILE(s_) (FOX ? (s_) : NT - 1 - (s_))
#define ATT_ISSUE(i, slot) do { const int tk_ = 64 * (i) - 48; int ta_ = tk_ + kkK; ta_ = ta_ < 0 ? 0 : ta_; int tb_ = tk_ + kkV; tb_ = tb_ < 0 ? 0 : tb_; \
        glds16(kcol + ta_ * 64, (unsigned)__builtin_amdgcn_readfirstlane(lds0 + (slot) * SLOT + wid * 1024)); \
        glds16(vcol + tb_ * 64, (unsigned)__builtin_amdgcn_readfirstlane(lds0 + (slot) * SLOT + 8192 + wid * 1024)); } while (0)
#define ATT_SKIP(i) (FOX ? (64 * (i) - 48 > tw0 + 31) : (64 * (i) - 48 >= tw0 + 31))
#define ATT_QK(P0, P1, i, slot) do { \
        if (FOX) { _Pragma("unroll") for (int g = 0; g < 4; ++g) { const f32x4 a_ = *(const LAS f32x4*)(kbs + 64 * (i) + 4 * hi + 8 * g), c_ = *(const LAS f32x4*)(kbs + 64 * (i) + 32 + 4 * hi + 8 * g); \
            _Pragma("unroll") for (int j = 0; j < 4; ++j) { P0[4 * g + j] = a_[j] - mref; P1[4 * g + j] = c_[j] - mref; } } } else { P0 = f32x16{}; P1 = f32x16{}; } \
        const LAS unsigned char* kp_ = lds + (slot) * SLOT + r32 * 128; \
        _Pragma("unroll") for (int d0 = 0; d0 < 4; ++d0) { const int co_ = ((2 * d0 + hi) ^ ((r32 >> 1) & 7)) * 16; const bf16x8 a0_ = *(const LAS bf16x8*)(kp_ + co_), a1_ = *(const LAS bf16x8*)(kp_ + co_ + 4096); \
            P0 = __builtin_amdgcn_mfma_f32_32x32x16_bf16(a0_, qr[d0], P0, 0, 0, 0); P1 = __builtin_amdgcn_mfma_f32_32x32x16_bf16(a1_, qr[d0], P1, 0, 0, 0); } } while (0)
    asm volatile("s_waitcnt vmcnt(0)" ::: "memory");
    bf16x8 qr[4];
    { const int tqc = tq < 0 ? 0 : tq; const bf16_t* qp = Qb + (rowbase + tqc) * D + colq + hi * 8;
#pragma unroll
      for (int d0 = 0; d0 < 4; ++d0) qr[d0] = *(const bf16x8*)(qp + d0 * 16); }
    asm volatile("" : "+v"(qr[0]), "+v"(qr[1]), "+v"(qr[2]), "+v"(qr[3]) :: "memory");
    ATT_ISSUE(ATT_TILE(0), 0);
    if (NT > 1) ATT_ISSUE(ATT_TILE(1), 1);
    if (NT > 2) ATT_ISSUE(ATT_TILE(2), 2);
    f32x16 o[2]; o[0] = f32x16{}; o[1] = f32x16{};
    float mref = 0.f, lsum = 0.f, carry = 1.f;
    if (NT > 2) asm volatile("s_waitcnt vmcnt(2) lgkmcnt(0)\n\ts_barrier" ::: "memory");
    else asm volatile("s_waitcnt vmcnt(0) lgkmcnt(0)\n\ts_barrier" ::: "memory");
    f32x16 c0, c1;
    bool skipc = ATT_SKIP(ATT_TILE(0));
    if (active && !skipc) ATT_QK(c0, c1, ATT_TILE(0), 0);
    for (int s = 0; s < NT; ++s) {
        const int i = ATT_TILE(s), inx = ATT_TILE(s + 1);
        const int sl_cur = s & 3, sl_nxt = (s + 1) & 3;
        if (s + 3 < NT) ATT_ISSUE(ATT_TILE(s + 3), (s + 3) & 3);
        const bool skipn = (s + 1 >= NT) || ATT_SKIP(inx);
        bf16x8 kf[8]; s16x4 vlo[8], vhi[8];
        if (active && !skipn) { const LAS unsigned char* kp_ = lds + sl_nxt * SLOT + r32 * 128;
#pragma unroll
            for (int d0 = 0; d0 < 4; ++d0) { const int co_ = ((2 * d0 + hi) ^ ((r32 >> 1) & 7)) * 16; kf[2 * d0] = *(const LAS bf16x8*)(kp_ + co_); kf[2 * d0 + 1] = *(const LAS bf16x8*)(kp_ + co_ + 4096); } }
        if (!FOX && active && !skipc) { const LAS unsigned char* vp = lds + sl_cur * SLOT + 8192 + ((lane >> 4) & 1) * 32 + (lane & 3) * 8 + (4 * hi + ((lane & 15) >> 2)) * 64;
#pragma unroll
            for (int q = 0; q < 4; ++q) { vlo[q] = vtr(vp + q * 1024); vhi[q] = vtr(vp + q * 1024 + 512); } }
        __builtin_amdgcn_sched_barrier(0);
        if (active && !skipc) {
            const int tk0 = 64 * i - 48;
            const bool needmask = (i == 0) || (tk0 + 63 >= tw0);
            if (FOX) {
                if (needmask) {
#pragma unroll
                    for (int r = 0; r < 16; ++r) { const int tk = tk0 + crow(r, hi); if (!(tk >= 0 && tk <= tq)) c0[r] = -1e30f; if (!(tk + 32 >= 0 && tk + 32 <= tq)) c1[r] = -1e30f; } }
                float rm = __builtin_fmaxf(c0[0], c1[0]);
#pragma unroll
                for (int r = 1; r < 16; ++r) rm = __builtin_fmaxf(__builtin_fmaxf(rm, c0[r]), c1[r]);
                { auto rr = __builtin_amdgcn_permlane32_swap(__float_as_uint(rm), __float_as_uint(rm), false, false); rm = __builtin_fmaxf(__uint_as_float(rr[0]), __uint_as_float(rr[1])); }
                if (s == 0 || __any(rm > 8.f)) {
                    const float dl = (s == 0) ? rm : __builtin_fmaxf(rm, 0.f); mref += dl;
                    const float f = __builtin_amdgcn_exp2f(-dl); lsum *= f;
#pragma unroll
                    for (int r = 0; r < 16; ++r) { c0[r] -= dl; c1[r] -= dl; o[0][r] *= f; o[1][r] *= f; }
                }
                float sacc = 0.f;
#pragma unroll
                for (int r = 0; r < 16; ++r) { c0[r] = __builtin_amdgcn_exp2f(c0[r]); c1[r] = __builtin_amdgcn_exp2f(c1[r]); sacc += c0[r] + c1[r]; }
                lsum += sacc;
            } else {
                f32x16 k0, k1;
#pragma unroll
                for (int r = 0; r < 16; ++r) { k0[r] = __builtin_amdgcn_rcpf(1.f + __builtin_amdgcn_exp2f(c0[r])); k1[r] = __builtin_amdgcn_rcpf(1.f + __builtin_amdgcn_exp2f(c1[r])); c0[r] = 1.f - k0[r]; c1[r] = 1.f - k1[r]; }
                if (needmask) {
#pragma unroll
                    for (int r = 0; r < 16; ++r) { const int tk = tk0 + crow(r, hi); const bool v0 = tk >= 0 && tk < tq, v1 = tk + 32 >= 0 && tk + 32 < tq;
                        k0[r] = v0 ? k0[r] : 1.f; c0[r] = v0 ? c0[r] : 0.f; k1[r] = v1 ? k1[r] : 1.f; c1[r] = v1 ? c1[r] : 0.f; } }
                float run = carry;
#pragma unroll
                for (int hf = 1; hf >= 0; --hf)
#pragma unroll
                    for (int g = 3; g >= 0; --g) {
                        f32x16& kk = hf ? k1 : k0; f32x16& pp = hf ? c1 : c0;
                        const float G = (kk[4 * g] * kk[4 * g + 1]) * (kk[4 * g + 2] * kk[4 * g + 3]);
                        auto rr = __builtin_amdgcn_permlane32_swap(__float_as_uint(G), __float_as_uint(G), false, false);
                        const float t3 = run * (hi == 0 ? __uint_as_float(rr[1]) : 1.f);
                        const float t2 = t3 * kk[4 * g + 3], t1 = t2 * kk[4 * g + 2], t0 = t1 * kk[4 * g + 1];
                        pp[4 * g + 3] *= t3; pp[4 * g + 2] *= t2; pp[4 * g + 1] *= t1; pp[4 * g] *= t0;
                        run *= __uint_as_float(rr[0]) * __uint_as_float(rr[1]);
                    }
                carry = run;
            }
            u32x4 pw[4];
#pragma unroll
            for (int k = 0; k < 2; ++k) { pw[k] = (u32x4){cvtpk(c0[8 * k], c0[8 * k + 1]), cvtpk(c0[8 * k + 2], c0[8 * k + 3]), cvtpk(c0[8 * k + 4], c0[8 * k + 5]), cvtpk(c0[8 * k + 6], c0[8 * k + 7])};
                pw[2 + k] = (u32x4){cvtpk(c1[8 * k], c1[8 * k + 1]), cvtpk(c1[8 * k + 2], c1[8 * k + 3]), cvtpk(c1[8 * k + 4], c1[8 * k + 5]), cvtpk(c1[8 * k + 6], c1[8 * k + 7])}; }
            { const LAS unsigned char* vp = lds + sl_cur * SLOT + 8192 + ((lane >> 4) & 1) * 32 + (lane & 3) * 8 + (4 * hi + ((lane & 15) >> 2)) * 64;
              if (FOX) {
#pragma unroll
                  for (int q = 0; q < 4; ++q) { vlo[q] = vtr(vp + q * 1024); vhi[q] = vtr(vp + q * 1024 + 512); } }
#pragma unroll
              for (int q = 0; q < 4; ++q) { vlo[4 + q] = vtr(vp + 4096 + q * 1024); vhi[4 + q] = vtr(vp + 4096 + q * 1024 + 512); } }
#pragma unroll
            for (int dh = 0; dh < 2; ++dh)
#pragma unroll
                for (int kg = 0; kg < 4; ++kg) { const int q = dh * 4 + kg;
                    const bf16x8 vf = (bf16x8){vlo[q][0], vlo[q][1], vlo[q][2], vlo[q][3], vhi[q][0], vhi[q][1], vhi[q][2], vhi[q][3]};
                    o[dh] = __builtin_amdgcn_mfma_f32_32x32x16_bf16(vf, __builtin_bit_cast(bf16x8, pw[kg]), o[dh], 0, 0, 0); }
        }
        if (active && !skipn) {
            if (FOX) {
#pragma unroll
                for (int g = 0; g < 4; ++g) { const f32x4 a_ = *(const LAS f32x4*)(kbs + 64 * inx + 4 * hi + 8 * g), c_ = *(const LAS f32x4*)(kbs + 64 * inx + 32 + 4 * hi + 8 * g);
#pragma unroll
                    for (int j = 0; j < 4; ++j) { c0[4 * g + j] = a_[j] - mref; c1[4 * g + j] = c_[j] - mref; } }
            } else { c0 = f32x16{}; c1 = f32x16{}; }
#pragma unroll
            for (int d0 = 0; d0 < 4; ++d0) { c0 = __builtin_amdgcn_mfma_f32_32x32x16_bf16(kf[2 * d0], qr[d0], c0, 0, 0, 0); c1 = __builtin_amdgcn_mfma_f32_32x32x16_bf16(kf[2 * d0 + 1], qr[d0], c1, 0, 0, 0); } }
        skipc = skipn;
        if (s + 3 < NT) asm volatile("s_waitcnt vmcnt(2) lgkmcnt(0)\n\ts_barrier" ::: "memory");
        else asm volatile("s_waitcnt vmcnt(0) lgkmcnt(0)\n\ts_barrier" ::: "memory");
    }
#undef ATT_ISSUE
#undef ATT_TILE
#undef ATT_SKIP
#undef ATT_QK
    if (active) {
        float inv = 1.f;
        if (FOX) { auto rr = __builtin_amdgcn_permlane32_swap(__float_as_uint(lsum), __float_as_uint(lsum), false, false); inv = 1.f / (__uint_as_float(rr[0]) + __uint_as_float(rr[1])); }
        if (tq >= 0) { bf16_t* op = O + (rowbase + tq) * D + (FOX ? 512 : 0) + h * 64 + 4 * hi;
#pragma unroll
            for (int dh = 0; dh < 2; ++dh)
#pragma unroll
                for (int g = 0; g < 4; ++g) { u32x2 w; w.x = cvtpk(o[dh][4 * g] * inv, o[dh][4 * g + 1] * inv); w.y = cvtpk(o[dh][4 * g + 2] * inv, o[dh][4 * g + 3] * inv);
                    *(u32x2*)(op + 32 * dh + 8 * g) = w; } }
    }
}
}

#define XB_TMO      128
#define XB_XCNT(j)  (256  + 64 * (j))
#define XB_XSUB(j)  (1280 + 64 * (j))
#define XB_XGEN(j)  (2304 + 64 * (j))
#define XB_TOP      3328
#define XB_TOPGEN   3392
#define XCD_BAR_WORDS 3456
#define XB_SPIN_CAP (1u << 18)
__device__ __forceinline__ unsigned xb_ld(unsigned* p)              { return __hip_atomic_load(p, __ATOMIC_RELAXED, __HIP_MEMORY_SCOPE_AGENT); }
__device__ __forceinline__ unsigned xb_add(unsigned* p, unsigned v) { return __hip_atomic_fetch_add(p, v, __ATOMIC_RELAXED, __HIP_MEMORY_SCOPE_AGENT); }
__device__ __forceinline__ unsigned xb_xcc_id() { return (unsigned)__builtin_amdgcn_s_getreg((3 << 11) | 20) & 0xFu; }
#define XB_SPIN(cond, bar) do { unsigned _sp = 0; while (cond) { __builtin_amdgcn_s_sleep(1); \
    if ((++_sp & 255u) == 0u) { if (xb_ld(&(bar)[XB_TMO])) break; if (_sp > XB_SPIN_CAP) { atomicAdd(&(bar)[XB_TMO], 1u); break; } } } } while (0)
struct XcdBarrier { unsigned* bar; unsigned x; volatile LAS unsigned* st; };
__device__ __forceinline__ XcdBarrier xcd_barrier_post(unsigned* bar, volatile LAS unsigned* st) {
    XcdBarrier b; b.bar = bar; b.x = xb_xcc_id(); b.st = st;
    if (threadIdx.x == 0) (void)xb_add(&bar[XB_XCNT(b.x)], 1u);
    return b;
}
__device__ __forceinline__ void xcd_barrier_complete(unsigned* bar, unsigned x, unsigned& nloc, unsigned& nx) {
    const unsigned G = gridDim.x * gridDim.y * gridDim.z;
    unsigned sum, cnt, mine, sp = 0u;
    for (;;) {
        sum = 0u; cnt = 0u; mine = 0u;
#pragma unroll
        for (unsigned j = 0; j < 16; ++j) { const unsigned c = xb_ld(&bar[XB_XCNT(j)]); sum += c; cnt += (c > 0u) ? 1u : 0u; mine = (j == x) ? c : mine; }
        if (sum == G) break;
        __builtin_amdgcn_s_sleep(1);
        if ((++sp & 255u) == 0u) { if (xb_ld(&bar[XB_TMO])) break; if (sp > XB_SPIN_CAP) { atomicAdd(&bar[XB_TMO], 1u); break; } }
    }
    nloc = mine > 0u ? mine : 1u; nx = cnt > 0u ? cnt : 1u;
}
__device__ __forceinline__ void xcd_barrier(const XcdBarrier& b) {
    asm volatile("s_waitcnt vmcnt(0)" ::: "memory");
    __syncthreads();
    if (threadIdx.x == 0) {
        unsigned* bar = b.bar;
        __builtin_amdgcn_s_waitcnt(0);
        unsigned nloc = b.st[0], nx = b.st[1];
        if (nloc == 0u) { xcd_barrier_complete(bar, b.x, nloc, nx); b.st[0] = nloc; b.st[1] = nx; }
        const unsigned old = xb_add(&bar[XB_XSUB(b.x)], 1u);
        const unsigned gen = old / nloc;
        if (old + 1u == (gen + 1u) * nloc) {
            __builtin_amdgcn_fence(__ATOMIC_RELEASE, "agent");
            asm volatile("s_waitcnt vmcnt(0)" ::: "memory");
            const unsigned og = xb_add(&bar[XB_TOP], 1u);
            const unsigned tg = og / nx;
            if (og + 1u == (tg + 1u) * nx) xb_add(&bar[XB_TOPGEN], 1u);
            else XB_SPIN(xb_ld(&bar[XB_TOPGEN]) == tg, bar);
            __builtin_amdgcn_fence(__ATOMIC_ACQUIRE, "agent");
            xb_add(&bar[XB_XGEN(b.x)], 1u);
            asm volatile("s_waitcnt vmcnt(0)" ::: "memory");
        } else {
            XB_SPIN(xb_ld(&bar[XB_XGEN(b.x)]) == gen, bar);
            __builtin_amdgcn_fence(__ATOMIC_ACQUIRE, "agent");
            asm volatile("s_waitcnt vmcnt(0)" ::: "memory");
        }
    }
    __syncthreads();
}

__device__ __forceinline__ void transpose_item(const float* W, int ldw, int K, bf16_t* WT, int k0, int dst0, int src0, const float* kscale, LAS float* scr, int lane) {
#pragma unroll 8
    for (int i = 0; i < 32; ++i) { const int kk = 2 * i + (lane >> 5); float v = W[(size_t)(k0 + kk) * ldw + src0 + (lane & 31)]; if (kscale) v *= kscale[k0 + kk]; scr[kk * 33 + (lane & 31)] = v; }
    asm volatile("s_waitcnt lgkmcnt(0)" ::: "memory");
    const int c = lane & 7;
#pragma unroll
    for (int j = 0; j < 4; ++j) { const int n = (lane >> 3) + 8 * j; const LAS float* s = scr + (8 * c) * 33 + n;
        u32x4 o; o.x = cvtpk(s[0 * 33], s[1 * 33]); o.y = cvtpk(s[2 * 33], s[3 * 33]); o.z = cvtpk(s[4 * 33], s[5 * 33]); o.w = cvtpk(s[6 * 33], s[7 * 33]);
        *(u32x4*)(WT + (size_t)(dst0 + n) * K + k0 + 8 * c) = o; }
    asm volatile("s_waitcnt lgkmcnt(0)" ::: "memory");
}

struct Args { const float *x, *meta, *g1, *w_in, *bf, *wbsb, *wbfx, *wout, *g2, *wup, *convw, *wdown, *gf; float* out; unsigned char* ws; };

constexpr int LDS_BYTES = 147456;
__global__ void __launch_bounds__(512, 2) fwd_mega(Args a) {
    extern __shared__ __attribute__((aligned(16))) unsigned char lds_[];
    LAS unsigned char* lds = (LAS unsigned char*)lds_;
    cg::grid_group grid = cg::this_grid();
    const int tid = threadIdx.x, lane = tid & 63, wave = __builtin_amdgcn_readfirstlane(tid >> 6);
    const int G = gridDim.x, bx = blockIdx.x;
    const int gw = bx * 8 + wave, NGW = G * 8;
    unsigned char* ws = a.ws;
    volatile LAS unsigned* misc = (volatile LAS unsigned*)(lds + LDS_BYTES - 64);
    if (tid < 16) misc[tid] = 0u;
    __syncthreads();
    const XcdBarrier xbar = xcd_barrier_post((unsigned*)(ws + WS_BAR), misc);
    float* ss1 = (float*)(ws + WS_SS1); float* ss2 = (float*)(ws + WS_SS2); float* fl = (float*)(ws + WS_FL); float* cum = (float*)(ws + WS_CUM); float* metah = (float*)(ws + WS_METAH);
    bf16_t* Win_t = (bf16_t*)(ws + WS_WIN); bf16_t* Wbsb_t = (bf16_t*)(ws + WS_WBSB); bf16_t* Wbfx_t = (bf16_t*)(ws + WS_WBFX); bf16_t* Wout_t = (bf16_t*)(ws + WS_WOUT);
    bf16_t* Wup_t = (bf16_t*)(ws + WS_WUP); bf16_t* Wdn_t = (bf16_t*)(ws + WS_WDN);
    bf16_t* XN = (bf16_t*)(ws + WS_XN); bf16_t* QKV = (bf16_t*)(ws + WS_QKV); bf16_t* GT = (bf16_t*)(ws + WS_G); bf16_t* H1B = GT; bf16_t* ACT = QKV; bf16_t* MG = XN; bf16_t* OB = (bf16_t*)(ws + WS_O); bf16_t* KVHB = (bf16_t*)(ws + WS_QKV + 129 * MiB);

    {
        LAS float* scr = (LAS float*)(lds + wave * 8704);
        LAS float* wfl = (LAS float*)(lds + 69632);
        for (int idx = tid; idx < 8192; idx += 512) { const int k = idx >> 3, j = idx & 7; wfl[j * 1024 + k] = a.w_in[(size_t)k * INCOLS + NQKV + j]; }
        for (int i = bx * 512 + tid; i < M; i += G * 512) { ss1[i] = 0.f; if (i < NB * SEQ) ss2[i] = 0.f; }
        constexpr int I_IN = 16 * 160, I_BR = 8 * 32, I_OUT = 16 * 32, I_UP = 16 * 176, I_DN = 44 * 32;
        constexpr int NITEMS = I_IN + 2 * I_BR + I_OUT + I_UP + I_DN;
        for (int it = gw; it < NITEMS; it += NGW) {
            int r = it;
            if (r < I_IN) { const int kb = r / 160, nb = r % 160, d0 = 32 * nb; transpose_item(a.w_in, INCOLS, D, Win_t, 64 * kb, d0, d0 < NQKV ? d0 : d0 + 8, nullptr, scr, lane); continue; } r -= I_IN;
            if (r < I_BR) { const int kb = r / 32, nb = r % 32; transpose_item(a.wbsb, D, 512, Wbsb_t, 64 * kb, 32 * nb, 32 * nb, nullptr, scr, lane); continue; } r -= I_BR;
            if (r < I_BR) { const int kb = r / 32, nb = r % 32; transpose_item(a.wbfx, D, 512, Wbfx_t, 64 * kb, 32 * nb, 32 * nb, nullptr, scr, lane); continue; } r -= I_BR;
            if (r < I_OUT) { const int kb = r / 32, nb = r % 32; transpose_item(a.wout, D, D, Wout_t, 64 * kb, 32 * nb, 32 * nb, nullptr, scr, lane); continue; } r -= I_OUT;
            if (r < I_UP) { const int kb = r / 176, nb = r % 176, d0 = 32 * nb, pn = d0 >> 8, bj = (d0 >> 7) & 1, j = d0 & 127;
                transpose_item(a.wup, NUP, D, Wup_t, 64 * kb, d0, bj * DFF + 128 * pn + j, a.g2, scr, lane); continue; } r -= I_UP;
            { const int kb = r / 32, nb = r % 32; transpose_item(a.wdown, D, DFF, Wdn_t, 64 * kb, 32 * nb, 32 * nb, nullptr, scr, lane); }
        }
        __syncthreads();
        f32x4 gv[4];
#pragma unroll
        for (int j = 0; j < 4; ++j) gv[j] = ((const f32x4*)a.g1)[lane + 64 * j];
        for (int m = gw; m < M; m += NGW) {
            const int b = m / L, t = m - b * L;
            const f32x4* xr = (const f32x4*)((t < NMETA) ? a.meta + (size_t)t * D : a.x + ((size_t)b * SEQ + (t - NMETA)) * D) + lane;
            f32x4 v[4]; float s = 0.f;
#pragma unroll
            for (int j = 0; j < 4; ++j) { v[j] = xr[64 * j]; s += (v[j].x * v[j].x + v[j].y * v[j].y) + (v[j].z * v[j].z + v[j].w * v[j].w); }
            const float r = __builtin_amdgcn_rsqf(wave_sum(s) * (1.f / D) + EPS);
#pragma unroll
            for (int j = 0; j < 4; ++j) v[j] = v[j] * r * gv[j];
            u32x2* o8 = (u32x2*)(XN + (size_t)m * D) + lane;
#pragma unroll
            for (int j = 0; j < 4; ++j) { u32x2 w; w.x = cvtpk(v[j].x, v[j].y); w.y = cvtpk(v[j].z, v[j].w); o8[64 * j] = w; }
            float mine = 0.f;
#pragma unroll
            for (int jj = 0; jj < 8; ++jj) { float d = 0.f;
#pragma unroll
                for (int j = 0; j < 4; ++j) { const f32x4 w = *(const LAS f32x4*)(wfl + jj * 1024 + 4 * (lane + 64 * j)); d += (v[j].x * w.x + v[j].y * w.y) + (v[j].z * w.z + v[j].w * w.w); }
                d = wave_sum(d); if (lane == jj) mine = d; }
            if (lane < 8) fl[(size_t)m * 8 + lane] = mine;
        }
    }
    grid.sync();

    {
        pg8::Gemm g{XN, Win_t, D, D, 256, 0}; pg8::StaticOrder S; S.init(M / 256, NIN / 256, G, bx);
        pg8::EpiIn E{QKV, KVHB, GT};
        pg8::gemm_phase<pg8::EpiIn>(lds, g, S, E);
        if (wave == 0) for (int seq = bx; seq < NB * 8; seq += G) { const int b = seq >> 3, h = seq & 7; const float bias = a.bf[h]; float carry = 0.f;
            for (int c = 0; c < (L + 63) / 64; ++c) { const int t = 64 * c + lane; float v = 0.f;
                if (t < L) { const float xx = fl[((size_t)b * L + t) * 8 + h] + bias; v = __builtin_fminf(xx, 0.f) * LOG2E - __builtin_amdgcn_logf(1.f + __builtin_amdgcn_exp2f(-__builtin_fabsf(xx) * LOG2E)); }
#pragma unroll
                for (int o = 1; o < 64; o <<= 1) { const float n = __shfl_up(v, o); if (lane >= o) v += n; }
                if (t < L) cum[(size_t)seq * L + t] = carry + v;
                carry += __shfl(v, 63); } }
    }
    xcd_barrier(xbar);

#ifndef ATT_REPEAT
#define ATT_REPEAT 1
#endif
    for (int rep = 0; rep < ATT_REPEAT; ++rep)
    for (int bh = bx; bh < NB * 8; bh += G) {
        const int b = bh >> 3, h = bh & 7;
        for (int jj = 0; jj < 9; ++jj) { const int j = 7 - jj; const bool mt = j < 0; att::unit<false>(QKV, KVHB, OB, nullptr, b, h, mt ? -16 : NMETA + 256 * j, mt ? 1 : 8, mt ? 1 : 4 * j + 5, lds); }
        for (int jj = 0; jj < 9; ++jj) { const int j = 7 - jj; const bool mt = j < 0; att::unit<true>(QKV, KVHB, OB, cum + (size_t)bh * L, b, h, mt ? -16 : NMETA + 256 * j, mt ? 1 : 8, mt ? 1 : 4 * j + 5, lds); }
    }
    xcd_barrier(xbar);

    {
        pg8::StaticOrder S; S.init(M / 256, D / 256, G, bx);
        { pg8::Gemm g{OB, Wbsb_t, D, 512, 256, 0}; pg8::EpiBr<0> E{GT, MG}; pg8::gemm_phase<pg8::EpiBr<0>>(lds, g, S, E); }
        { pg8::Gemm g{OB + 512, Wbfx_t, D, 512, 256, 0}; pg8::EpiBr<1> E{GT, MG}; pg8::gemm_phase<pg8::EpiBr<1>>(lds, g, S, E); }
    }
    xcd_barrier(xbar);

    {
        pg8::Gemm g{MG, Wout_t, D, D, 256, 0}; pg8::StaticOrder S; S.init(M / 256, D / 256, G, bx);
        pg8::EpiOut E{a.x, a.meta, a.out, metah, H1B, ss1};
        pg8::gemm_phase<pg8::EpiOut>(lds, g, S, E);
    }
    xcd_barrier(xbar);

    {
        pg8::Gemm g{H1B, Wup_t, D, D, 254, -2}; pg8::StaticOrder S; S.init(261, NUP / 256, G, bx);
        pg8::EpiUp E{ss1, a.convw, ACT, (LAS float*)(lds + pg8::STAGE_BYTES)};
        pg8::gemm_phase<pg8::EpiUp>(lds, g, S, E);
    }
    xcd_barrier(xbar);

    {
        pg8::Gemm g{ACT, Wdn_t, DFF, DFF, 256, 0}; pg8::StaticOrder S; S.init(NB * SEQ / 256, D / 256, G, bx);
        pg8::EpiDown E{a.out, ss2};
        pg8::gemm_phase<pg8::EpiDown>(lds, g, S, E);
    }
    xcd_barrier(xbar);

    {
        f32x4 gv[4];
#pragma unroll
        for (int j = 0; j < 4; ++j) gv[j] = ((const f32x4*)a.gf)[lane + 64 * j];
        for (int m = gw; m < NB * SEQ; m += NGW) {
            const float r = __builtin_amdgcn_rsqf(ss2[m] * (1.f / D) + EPS);
            f32x4* p = (f32x4*)(a.out + (size_t)m * D) + lane;
#pragma unroll
            for (int j = 0; j < 4; ++j) p[64 * j] = p[64 * j] * r * gv[j];
        }
    }
}

extern "C" void kernel_launch(void* const* d_in, const int* in_sizes, int n_in, void* d_out, int out_size, void* d_ws, size_t ws_size, hipStream_t stream) {
    static int grid = 0;
    if (grid == 0) {
        if (n_in != 13 || out_size != NB * SEQ * D || ws_size < WS_END) { fprintf(stderr, "kernel_launch: unexpected shapes (n_in %d out %d ws %zu)\n", n_in, out_size, ws_size); grid = -1; return; }
        int dev = 0, cus = 0, per_cu = 0;
        (void)hipGetDevice(&dev);
        (void)hipDeviceGetAttribute(&cus, hipDeviceAttributeMultiprocessorCount, dev);
        (void)hipFuncSetAttribute((const void*)fwd_mega, hipFuncAttributeMaxDynamicSharedMemorySize, LDS_BYTES);
        (void)hipOccupancyMaxActiveBlocksPerMultiprocessor(&per_cu, (const void*)fwd_mega, 512, LDS_BYTES);
        if (per_cu < 1) per_cu = 1;
        grid = cus * per_cu;
    }
    if (grid < 0) return;
    Args a{};
    a.x = (const float*)d_in[0]; a.meta = (const float*)d_in[1]; a.g1 = (const float*)d_in[2]; a.w_in = (const float*)d_in[3]; a.bf = (const float*)d_in[4];
    a.wbsb = (const float*)d_in[5]; a.wbfx = (const float*)d_in[6]; a.wout = (const float*)d_in[7]; a.g2 = (const float*)d_in[8]; a.wup = (const float*)d_in[9];
    a.convw = (const float*)d_in[10]; a.wdown = (const float*)d_in[11]; a.gf = (const float*)d_in[12]; a.out = (float*)d_out; a.ws = (unsigned char*)d_ws;
    (void)hipMemsetAsync((char*)d_ws + WS_BAR, 0, WS_BAR_BYTES, stream);
    void* args[] = {&a};
    hipError_t e = hipLaunchCooperativeKernel((const void*)fwd_mega, dim3(grid), dim3(512), args, LDS_BYTES, stream);
    if (e != hipSuccess) fprintf(stderr, "cooperative launch failed: %s (grid %d)\n", hipGetErrorString(e), grid);
}
```
